# Optimizing an MI355X kernel written in HIP

```python
import math
import jax, jax.numpy as jnp
from jax import lax
import numpy as np

D_MODEL = 1024
BATCH = 16
SEQ = 2048
DEPTH = 1

PLE_DIM = 256
RMS_EPS = 1e-6
N_BRANCH = 2
S5_WIDTH = 512
S5_GROUP = 16
S5_GROUPS = S5_WIDTH // S5_GROUP
S5_STATE = 64
SSD_WIDTH = 1536
SSD_HEADDIM = 64
SSD_HEADS = SSD_WIDTH // SSD_HEADDIM
SSD_GROUPS = 4
SSD_HPG = SSD_HEADS // SSD_GROUPS
SSD_STATE = 128
SSD_CONV = 4
SSD_CHUNK = 128
SSD_BC = SSD_GROUPS * SSD_STATE
SSD_CONV_DIM = SSD_WIDTH + 2 * SSD_BC
DT_MIN, DT_MAX = 1e-3, 1e-1
_SIZES = (S5_WIDTH, S5_WIDTH, SSD_WIDTH, SSD_CONV_DIM, SSD_HEADS, N_BRANCH * D_MODEL)
IN_PROJ_DIM = int(sum(_SIZES))
SPLITS = tuple(int(v) for v in np.cumsum(_SIZES)[:-1])

kernel_name = "hybrid_s5_ssd_gated_block"


def rms_norm(x, w):
    xf = x.astype(jnp.float32)
    y = xf * lax.rsqrt(jnp.mean(xf * xf, axis=-1, keepdims=True) + RMS_EPS)
    return (y * w.astype(jnp.float32)).astype(x.dtype)


def s5_mixer(u, a_re, a_im, b_re, b_im, c_re, c_im, d, log_step, w_glu, b_glu):
    f32 = jnp.float32
    bsz, L, _ = u.shape
    uf = u.astype(f32).reshape(bsz, L, S5_GROUPS, S5_GROUP)
    a_re = a_re.astype(f32); a_im = a_im.astype(f32)
    step = jnp.exp(log_step.astype(f32))[:, None]
    mag = jnp.exp(a_re * step)
    lb_re = mag * jnp.cos(a_im * step)
    lb_im = mag * jnp.sin(a_im * step)
    den = a_re * a_re + a_im * a_im
    n_re = lb_re - 1.0
    n_im = lb_im
    f_re = (n_re * a_re + n_im * a_im) / den
    f_im = (n_im * a_re - n_re * a_im) / den
    b_re = b_re.astype(f32); b_im = b_im.astype(f32)
    bb_re = f_re[..., None] * b_re - f_im[..., None] * b_im
    bb_im = f_re[..., None] * b_im + f_im[..., None] * b_re
    bu_re = jnp.einsum('gph,blgh->blgp', bb_re, uf)
    bu_im = jnp.einsum('gph,blgh->blgp', bb_im, uf)
    ar = jnp.broadcast_to(lb_re, (1, L, S5_GROUPS, S5_STATE))
    ai = jnp.broadcast_to(lb_im, (1, L, S5_GROUPS, S5_STATE))

    def combine(e1, e2):
        a1r, a1i, b1r, b1i = e1
        a2r, a2i, b2r, b2i = e2
        return (a2r * a1r - a2i * a1i,
                a2r * a1i + a2i * a1r,
                a2r * b1r - a2i * b1i + b2r,
                a2r * b1i + a2i * b1r + b2i)

    _, _, s_re, s_im = lax.associative_scan(combine, (ar, ai, bu_re, bu_im), axis=1)
    y = (jnp.einsum('ghp,blgp->blgh', c_re.astype(f32), s_re)
         - jnp.einsum('ghp,blgp->blgh', c_im.astype(f32), s_im))
    y = y.reshape(bsz, L, S5_WIDTH) + d.astype(f32) * u.astype(f32)
    y = jax.nn.gelu(y)
    y = y * jax.nn.sigmoid(y @ w_glu.astype(f32) + b_glu.astype(f32))
    return y.astype(u.dtype)


def causal_depthwise_conv(x, w, b):
    C = x.shape[-1]
    y = lax.conv_general_dilated(x, w[:, None, :], window_strides=(1,),
                                 padding=[(SSD_CONV - 1, 0)],
                                 dimension_numbers=('NWC', 'WIO', 'NWC'),
                                 feature_group_count=C)
    return y + b


def ssd_mixer(z, xbc, dt_raw, conv_w, conv_b, dt_bias, a_log, d_skip, norm_w):
    f32 = jnp.float32
    bsz, L, _ = xbc.shape
    nc = L // SSD_CHUNK
    G, J, P, N, CH = SSD_GROUPS, SSD_HPG, SSD_HEADDIM, SSD_STATE, SSD_CHUNK
    xbc = jax.nn.silu(causal_depthwise_conv(xbc.astype(f32), conv_w.astype(f32), conv_b.astype(f32)))
    xs, bm, cm = jnp.split(xbc, [SSD_WIDTH, SSD_WIDTH + SSD_BC], axis=-1)
    dt = jax.nn.softplus(dt_raw.astype(f32) + dt_bias.astype(f32))
    a = -jnp.exp(a_log.astype(f32))
    xs = xs.reshape(bsz, nc, CH, G, J, P)
    bm = bm.reshape(bsz, nc, CH, G, N)
    cm = cm.reshape(bsz, nc, CH, G, N)
    dtc = dt.reshape(bsz, nc, CH, G, J)
    xdt = xs * dtc[..., None]
    da = jnp.transpose((dt * a).reshape(bsz, nc, CH, G, J), (0, 1, 3, 4, 2))
    a_cum = jnp.cumsum(da, axis=-1)
    seg = a_cum[..., :, None] - a_cum[..., None, :]
    causal = jnp.tril(jnp.ones((CH, CH), dtype=bool))
    lmat = jnp.exp(jnp.where(causal, seg, -jnp.inf))
    scores = jnp.einsum('bclgn,bcsgn->bcgls', cm, bm)
    wts = scores[:, :, :, None] * lmat
    y_diag = jnp.einsum('bcgjls,bcsgjp->bclgjp', wts, xdt)
    decay_states = jnp.exp(a_cum[..., -1:] - a_cum)
    states = jnp.einsum('bclgn,bcgjl,bclgjp->bcgjpn', bm, decay_states, xdt)
    chunk_decay = jnp.exp(a_cum[..., -1])

    def step(carry, inp):
        dec, st = inp
        return carry * dec[..., None, None] + st, carry

    init = jnp.zeros((bsz, G, J, P, N), f32)
    _, prev = lax.scan(step, init, (jnp.moveaxis(chunk_decay, 1, 0), jnp.moveaxis(states, 1, 0)))
    prev = jnp.moveaxis(prev, 0, 1)
    y_off = jnp.einsum('bclgn,bcgjpn,bcgjl->bclgjp', cm, prev, jnp.exp(a_cum))
    y = y_diag + y_off + xs * d_skip.astype(f32).reshape(G, J)[:, :, None]
    y = y.reshape(bsz, L, SSD_WIDTH)
    yg = (y * jax.nn.silu(z.astype(f32))).reshape(bsz, L, G, SSD_WIDTH // G)
    yg = yg * lax.rsqrt(jnp.mean(yg * yg, axis=-1, keepdims=True) + RMS_EPS)
    y = yg.reshape(bsz, L, SSD_WIDTH) * norm_w.astype(f32)
    return y.astype(z.dtype)


def setup_inputs(seed: int = 0) -> dict:
    key = jax.random.key(seed)
    ks = iter(jax.random.split(key, 40))
    nrm = lambda shape, s: jax.random.normal(next(ks), shape, jnp.float32) * s
    D = D_MODEL
    x = jax.random.normal(next(ks), (BATCH, SEQ, D), jnp.float32)
    p = jax.random.normal(next(ks), (DEPTH, BATCH, SEQ, PLE_DIM), jnp.float32)
    norm_w = 1.0 + nrm((DEPTH, D), 0.02)
    w_in = nrm((DEPTH, D, IN_PROJ_DIM), D ** -0.5)
    n_idx = jnp.arange(S5_STATE, dtype=jnp.float32)
    s5_a_re = -0.5 + nrm((DEPTH, S5_GROUPS, S5_STATE), 0.01)
    s5_a_im = math.pi * n_idx + nrm((DEPTH, S5_GROUPS, S5_STATE), 0.01)
    s5_b_re = nrm((DEPTH, S5_GROUPS, S5_STATE, S5_GROUP), (2 * S5_GROUP) ** -0.5)
    s5_b_im = nrm((DEPTH, S5_GROUPS, S5_STATE, S5_GROUP), (2 * S5_GROUP) ** -0.5)
    s5_c_re = nrm((DEPTH, S5_GROUPS, S5_GROUP, S5_STATE), S5_STATE ** -0.5)
    s5_c_im = nrm((DEPTH, S5_GROUPS, S5_GROUP, S5_STATE), S5_STATE ** -0.5)
    s5_d = nrm((DEPTH, S5_WIDTH), 1.0)
    s5_log_step = jax.random.uniform(next(ks), (DEPTH, S5_GROUPS), jnp.float32,
                                     math.log(DT_MIN), math.log(DT_MAX))
    s5_w_glu = nrm((DEPTH, S5_WIDTH, S5_WIDTH), S5_WIDTH ** -0.5)
    s5_b_glu = nrm((DEPTH, S5_WIDTH), 0.01)
    ssd_conv_w = nrm((DEPTH, SSD_CONV, SSD_CONV_DIM), SSD_CONV ** -0.5)
    ssd_conv_b = nrm((DEPTH, SSD_CONV_DIM), 0.01)
    dt0 = jnp.exp(jax.random.uniform(next(ks), (DEPTH, SSD_HEADS), jnp.float32,
                                     math.log(DT_MIN), math.log(DT_MAX)))
    ssd_dt_bias = dt0 + jnp.log(-jnp.expm1(-dt0))
    ssd_a_log = jnp.log(jax.random.uniform(next(ks), (DEPTH, SSD_HEADS), jnp.float32, 1.0, 16.0))
    ssd_d = 1.0 + nrm((DEPTH, SSD_HEADS), 0.1)
    ssd_norm_w = 1.0 + nrm((DEPTH, SSD_WIDTH), 0.02)
    w_br_s5 = nrm((DEPTH, S5_WIDTH, D), S5_WIDTH ** -0.5)
    w_br_ssd = nrm((DEPTH, SSD_WIDTH, D), SSD_WIDTH ** -0.5)
    w_out = nrm((DEPTH, D, D), D ** -0.5)
    ple_norm_w = 1.0 + nrm((DEPTH, D), 0.02)
    w_ple_gate = nrm((DEPTH, D, D), D ** -0.5)
    w_ple_proj = nrm((DEPTH, PLE_DIM, D), PLE_DIM ** -0.5)
    final_norm_w = 1.0 + nrm((D,), 0.02)
    return {"x": x, "p": p, "norm_w": norm_w, "w_in": w_in,
            "s5_a_re": s5_a_re, "s5_a_im": s5_a_im, "s5_b_re": s5_b_re, "s5_b_im": s5_b_im,
            "s5_c_re": s5_c_re, "s5_c_im": s5_c_im, "s5_d": s5_d, "s5_log_step": s5_log_step,
            "s5_w_glu": s5_w_glu, "s5_b_glu": s5_b_glu,
            "ssd_conv_w": ssd_conv_w, "ssd_conv_b": ssd_conv_b, "ssd_dt_bias": ssd_dt_bias,
            "ssd_a_log": ssd_a_log, "ssd_d": ssd_d, "ssd_norm_w": ssd_norm_w,
            "w_br_s5": w_br_s5, "w_br_ssd": w_br_ssd, "w_out": w_out,
            "ple_norm_w": ple_norm_w, "w_ple_gate": w_ple_gate, "w_ple_proj": w_ple_proj,
            "final_norm_w": final_norm_w}


def reference(x, p, norm_w, w_in, s5_a_re, s5_a_im, s5_b_re, s5_b_im, s5_c_re, s5_c_im,
              s5_d, s5_log_step, s5_w_glu, s5_b_glu, ssd_conv_w, ssd_conv_b, ssd_dt_bias,
              ssd_a_log, ssd_d, ssd_norm_w, w_br_s5, w_br_ssd, w_out, ple_norm_w,
              w_ple_gate, w_ple_proj, final_norm_w):
    h = x
    for i in range(DEPTH):
        hn = rms_norm(h, norm_w[i])
        proj = hn @ w_in[i]
        s5_u, s5_z, ssd_z, ssd_xbc, ssd_dt, gate_logits = jnp.split(proj, SPLITS, axis=-1)
        y5 = s5_mixer(s5_u, s5_a_re[i], s5_a_im[i], s5_b_re[i], s5_b_im[i], s5_c_re[i],
                      s5_c_im[i], s5_d[i], s5_log_step[i], s5_w_glu[i], s5_b_glu[i])
        y5 = y5 * jax.nn.silu(s5_z)
        yss = ssd_mixer(ssd_z, ssd_xbc, ssd_dt, ssd_conv_w[i], ssd_conv_b[i], ssd_dt_bias[i],
                        ssd_a_log[i], ssd_d[i], ssd_norm_w[i])
        g5, gss = jnp.split(jax.nn.sigmoid(gate_logits), N_BRANCH, axis=-1)
        merged = g5 * (y5 @ w_br_s5[i]) + gss * (yss @ w_br_ssd[i])
        h = h + merged @ w_out[i]
        ple_gate = jax.nn.sigmoid(rms_norm(h, ple_norm_w[i]) @ w_ple_gate[i])
        h = h + ple_gate * (p[i] @ w_ple_proj[i])
    return rms_norm(h, final_norm_w)
```

```cpp
#include <hip/hip_runtime.h>
#include <hip/hip_cooperative_groups.h>
#include <cstdio>
namespace cg = cooperative_groups;

#define LAS __attribute__((address_space(3)))
typedef unsigned short bf16_t;
typedef short bf16x8 __attribute__((ext_vector_type(8)));
typedef float f32x4 __attribute__((ext_vector_type(4)));
typedef float f32x2 __attribute__((ext_vector_type(2)));
typedef unsigned u32x4 __attribute__((ext_vector_type(4)));
typedef unsigned u32x2 __attribute__((ext_vector_type(2)));

constexpr int T_TOK = 32768, DM = 1024, SEQ = 2048, NBATCH = 16, NCHUNK = 16, CH = 128;
constexpr int LDA_SEG = 2560;
constexpr int N_INP = 7168;
constexpr size_t MiB = 1ull << 20;
constexpr size_t OFF_SEGA = 0;
constexpr size_t OFF_SEGB = 160 * MiB;
constexpr size_t OFF_STATES = 320 * MiB;
constexpr size_t OFF_XN = 416 * MiB;
constexpr size_t OFF_WIN = 480 * MiB;
constexpr size_t OFF_DTV = 495 * MiB;
constexpr size_t OFF_E = 498 * MiB;
constexpr size_t OFF_TAB = 502 * MiB;
constexpr size_t OFF_WGLU = OFF_TAB;
constexpr size_t OFF_LAM = OFF_TAB + 512 * 1024;
constexpr size_t OFF_LAML = OFF_LAM + 16 * 1024;
constexpr size_t OFF_BBT = OFF_LAML + 16 * 1024;
constexpr size_t OFF_CWT = OFF_BBT + 256 * 1024;
constexpr size_t OFF_CDEC = OFF_CWT + 128 * 1024;
constexpr size_t OFF_BAR = OFF_CDEC + 32 * 1024;
constexpr size_t OFF_WDT = OFF_BAR + 16 * 1024;
constexpr size_t WS_NEED = 504 * MiB;
constexpr size_t OFF_M5 = OFF_SEGB;
constexpr size_t OFF_MERGED = OFF_SEGB + 64 * MiB;
constexpr size_t OFF_PBF = OFF_SEGB + 128 * MiB;
constexpr size_t OFF_W5T = OFF_SEGB + 144 * MiB;
constexpr size_t OFF_WSST = OFF_SEGB + 145 * MiB;
constexpr size_t OFF_WOUTT = OFF_SEGB + 148 * MiB;
constexpr size_t OFF_WPGT = OFF_SEGB + 150 * MiB;
constexpr size_t OFF_WPPT = OFF_SEGB + 152 * MiB;
constexpr size_t OFF_PLEP = OFF_STATES;
constexpr size_t OFF_SS1 = OFF_XN;
constexpr size_t OFF_SS2 = OFF_XN + 2 * MiB;

constexpr int LDS_BYTES = 131072 + 16;

struct Params {
    const float *x, *p, *norm_w, *w_in, *a_re, *a_im, *b_re, *b_im, *c_re, *c_im, *s5d, *logstep, *wglu, *bglu,
        *convw, *convb, *dtbias, *alog, *ssdd, *ssdnw, *wbr5, *wbrs, *wout, *plenw, *wpg, *wpp, *fnw;
    float* out; unsigned char* ws; int ph_lo, ph_hi, dry, pad;
};

typedef __bf16 bf16x2_t __attribute__((ext_vector_type(2)));
__device__ __forceinline__ unsigned pk2(float lo, float hi) { f32x2 v = {lo, hi}; bf16x2_t r = __builtin_convertvector(v, bf16x2_t); unsigned u; __builtin_memcpy(&u, &r, 4); return u; }
__device__ __forceinline__ float bflo(unsigned w) { return __uint_as_float(w << 16); }
__device__ __forceinline__ float bfhi(unsigned w) { return __uint_as_float(w & 0xffff0000u); }
__device__ __forceinline__ float sigmoidf_(float v) { return __builtin_amdgcn_rcpf(1.0f + __expf(-v)); }
__device__ __forceinline__ float siluf_(float v) { return v * __builtin_amdgcn_rcpf(1.0f + __expf(-v)); }
__device__ __forceinline__ float softplusf_(float v) { return fmaxf(v, 0.f) + log1pf(__expf(-fabsf(v))); }
__device__ __forceinline__ float geluf_(float v) { const float u = 0.7978845608028654f * (v + 0.044715f * v * v * v); const float t = 1.0f - 2.0f * __builtin_amdgcn_rcpf(1.0f + __expf(2.0f * u)); return 0.5f * v * (1.0f + t); }
__device__ __forceinline__ float wave_sum(float s) {
#pragma unroll
    for (int o = 32; o > 0; o >>= 1) s += __shfl_xor(s, o);
    return s;
}
__device__ __forceinline__ void unpack8(const u32x4 w, float (&f)[8]) { f[0] = bflo(w.x); f[1] = bfhi(w.x); f[2] = bflo(w.y); f[3] = bfhi(w.y); f[4] = bflo(w.z); f[5] = bfhi(w.z); f[6] = bflo(w.w); f[7] = bfhi(w.w); }
__device__ __forceinline__ u32x4 pack8(const float (&f)[8]) { u32x4 w; w.x = pk2(f[0], f[1]); w.y = pk2(f[2], f[3]); w.z = pk2(f[4], f[5]); w.w = pk2(f[6], f[7]); return w; }

namespace pg8 {
constexpr int BM = 256, BK = 64, HALF = 128, HTB = HALF * BK * 2, STAGE_BYTES = 8 * HTB, NXCD = 8, WGM = 8;
__device__ __forceinline__ int lds_byte(int r, int c) { const int st = (r >> 4) * 2 + (c >> 5), rr = r & 15, cc = c & 31, ob = rr * 64 + cc * 2; return st * 1024 + (ob ^ (((ob >> 9) & 1) << 5)); }
__device__ __forceinline__ void stage_rc(int b, int& R, int& C) { const int st = b / 1024, sb = b % 1024, swz = sb ^ (((sb >> 9) & 1) << 5); R = (st >> 1) * 16 + swz / 64; C = (st & 1) * 32 + (swz % 64) / 2; }
__device__ __forceinline__ int perm32(int rho) { const int n = rho >> 4, i = rho & 15; return 8 * (i >> 2) + 4 * n + (i & 3); }
struct Unit { int pm, pn; };
struct Gemm { const bf16_t* A; const bf16_t* Bt; int lda, ldb, M, N, K; };
struct StaticOrder {
    int nM, nN, nwg, G, c;
    __device__ void init(int M, int N, int G_, int c_) { nM = M / BM; nN = N / BM; nwg = nM * nN; G = G_; c = c_; }
    __device__ bool next(int i, Unit& u) const {
        const long L = (long)i * G + c; if (L >= nwg) return false;
        int wgid = (int)L; { const int q = nwg / NXCD, r = nwg % NXCD, xcd = wgid % NXCD, off = wgid / NXCD; wgid = (xcd < r ? xcd * (q + 1) : r * (q + 1) + (xcd - r) * q) + off; }
        const int nig = WGM * nN, gid = wgid / nig, fm = gid * WGM, gsz = (nM - fm) < WGM ? (nM - fm) : WGM;
        u.pm = fm + ((wgid % nig) % gsz); u.pn = (wgid % nig) / gsz; return true;
    }
};
template <class Epi>
__device__ __forceinline__ void gemm_phase(LAS unsigned char* lds, const Gemm g, const StaticOrder& S, const Epi& E) {
    const int tid = threadIdx.x, wid = __builtin_amdgcn_readfirstlane(tid >> 6), lane = tid & 63, wr = wid >> 2, wc = wid & 3, fr = lane & 15, fq = lane >> 4;
    const int K = g.K, nt = K / BK;
    unsigned voffA[2], voffB[2];
#pragma unroll
    for (int i = 0; i < 2; ++i) { int R, C; stage_rc(tid * 16 + i * 8192, R, C); const int Rb = (R & ~31) + perm32(R & 31);
        voffA[i] = (unsigned)(R * g.lda + C) * 2u; voffB[i] = (unsigned)(Rb * g.ldb + C) * 2u; }
    const size_t kstep = (size_t)(BK * 2);
    const size_t hstepA = (size_t)HALF * g.lda * 2, hstepB = (size_t)HALF * g.ldb * 2;
    const size_t tstepA = 2 * hstepA, tstepB = 2 * hstepB;
    const unsigned ldsw = (unsigned)wid * 1024u;
    const int aoff = lds_byte(wr * 64 + fr, fq * 8), boff = lds_byte(wc * 32 + fr, fq * 8);
#define PG8_SA(b, h) (((b) * 2 + (h)) * HTB)
#define PG8_SB(b, h) ((4 + (b) * 2 + (h)) * HTB)
#define PG8_STAGE(bufoff, gbase, voff) do { _Pragma("unroll") for (int _i = 0; _i < 2; ++_i) \
        __builtin_amdgcn_global_load_lds((const unsigned*)((const char*)(gbase) + (voff)[_i]), (LAS unsigned*)(lds + (bufoff) + ldsw + _i * 8192), 16, 0, 0); } while (0)
#define PG8_LDA(dst, b, h) do { _Pragma("unroll") for (int m = 0; m < 4; ++m) _Pragma("unroll") for (int k = 0; k < 2; ++k) dst[m][k] = *(const LAS bf16x8*)(lds + PG8_SA(b, h) + aoff + m * 2048 + k * 1024); } while (0)
#define PG8_LDB(dst, b, h) do { _Pragma("unroll") for (int n = 0; n < 2; ++n) _Pragma("unroll") for (int k = 0; k < 2; ++k) dst[n][k] = *(const LAS bf16x8*)(lds + PG8_SB(b, h) + boff + n * 2048 + k * 1024); } while (0)
#define PG8_MMA(ai, bj, At, Bt) do { __builtin_amdgcn_s_setprio(1); _Pragma("unroll") for (int m = 0; m < 4; ++m) _Pragma("unroll") for (int n = 0; n < 2; ++n) _Pragma("unroll") for (int k = 0; k < 2; ++k) \
        acc[ai][bj][m][n] = __builtin_amdgcn_mfma_f32_16x16x32_bf16(Bt[n][k], At[m][k], acc[ai][bj][m][n], 0, 0, 0); __builtin_amdgcn_s_setprio(0); } while (0)
#define PG8_WAIT_V(n) asm volatile("s_waitcnt vmcnt(" #n ")" ::: "memory")
#define PG8_WAIT_L(n) asm volatile("s_waitcnt lgkmcnt(" #n ")" ::: "memory")
#define PG8_BAR __builtin_amdgcn_s_barrier()
#define PG8_SCHED __builtin_amdgcn_sched_barrier(0)
    Unit cur, nxt; int ui = 0;
    if (!S.next(0, cur)) return;
    f32x4 acc[2][2][4][2];
#pragma unroll
    for (int a = 0; a < 2; ++a)
#pragma unroll
        for (int b = 0; b < 2; ++b)
#pragma unroll
            for (int m = 0; m < 4; ++m)
#pragma unroll
                for (int n = 0; n < 2; ++n) acc[a][b][m][n] = (f32x4){0.f, 0.f, 0.f, 0.f};
    bf16x8 At[4][2], B0[2][2], B1[2][2];
    const char* cA = (const char*)g.A + (size_t)cur.pm * tstepA; const char* cB = (const char*)g.Bt + (size_t)cur.pn * tstepB;
    PG8_STAGE(PG8_SB(0, 0), cB, voffB); PG8_STAGE(PG8_SA(0, 0), cA, voffA); PG8_STAGE(PG8_SB(0, 1), cB + hstepB, voffB); PG8_STAGE(PG8_SA(0, 1), cA + hstepA, voffA);
    if (wr == 1) PG8_BAR;
    PG8_WAIT_V(4); PG8_BAR;
    PG8_STAGE(PG8_SB(1, 0), cB + kstep, voffB); PG8_STAGE(PG8_SA(1, 0), cA + kstep, voffA); PG8_STAGE(PG8_SB(1, 1), cB + hstepB + kstep, voffB);
    PG8_WAIT_V(6); PG8_BAR;
    for (;;) {
        const bool has_next = S.next(ui + 1, nxt);
        const char* nA = has_next ? (const char*)g.A + (size_t)nxt.pm * tstepA : cA; const char* nB = has_next ? (const char*)g.Bt + (size_t)nxt.pn * tstepB : cB;
        for (int t = 0; t < nt; t += 2) {
            const bool last = (t == nt - 2);
            const char* a1 = cA + (size_t)(t + 1) * kstep;
            const char* a2 = last ? nA : cA + (size_t)(t + 2) * kstep; const char* b2 = last ? nB : cB + (size_t)(t + 2) * kstep;
            const char* a3 = a2 + kstep; const char* b3 = b2 + kstep;
            PG8_LDB(B0, 0, 0); PG8_SCHED; PG8_LDA(At, 0, 0); PG8_STAGE(PG8_SA(1, 1), a1 + hstepA, voffA);
            PG8_WAIT_L(8); PG8_BAR; PG8_WAIT_L(0); PG8_MMA(0, 0, At, B0); PG8_BAR; PG8_SCHED;
            PG8_LDB(B1, 0, 1); PG8_STAGE(PG8_SB(0, 0), b2, voffB);
            PG8_BAR; PG8_WAIT_L(0); PG8_MMA(0, 1, At, B1); PG8_BAR;
            PG8_LDA(At, 0, 1); PG8_STAGE(PG8_SA(0, 0), a2, voffA);
            PG8_BAR; PG8_WAIT_L(0); PG8_MMA(1, 0, At, B0); PG8_BAR; PG8_SCHED;
            PG8_STAGE(PG8_SB(0, 1), b2 + hstepB, voffB);
            PG8_WAIT_V(6); PG8_BAR; PG8_MMA(1, 1, At, B1); PG8_BAR;
            PG8_LDB(B0, 1, 0); PG8_SCHED; PG8_LDA(At, 1, 0); PG8_STAGE(PG8_SA(0, 1), a2 + hstepA, voffA);
            PG8_WAIT_L(8); PG8_BAR; PG8_WAIT_L(0); PG8_MMA(0, 0, At, B0); PG8_BAR; PG8_SCHED;
            PG8_LDB(B1, 1, 1); PG8_STAGE(PG8_SB(1, 0), b3, voffB);
            PG8_BAR; PG8_WAIT_L(0); PG8_MMA(0, 1, At, B1); PG8_BAR;
            PG8_LDA(At, 1, 1); PG8_STAGE(PG8_SA(1, 0), a3, voffA);
            PG8_BAR; PG8_WAIT_L(0); PG8_MMA(1, 0, At, B0); PG8_BAR; PG8_SCHED;
            PG8_STAGE(PG8_SB(1, 1), b3 + hstepB, voffB);
            PG8_WAIT_V(6); PG8_BAR; PG8_MMA(1, 1, At, B1); PG8_BAR;
        }
        E(acc, cur, wr, wc, fr, fq);
        if (!has_next) break;
#pragma unroll
        for (int a = 0; a < 2; ++a)
#pragma unroll
            for (int b = 0; b < 2; ++b)
#pragma unroll
                for (int m = 0; m < 4; ++m)
#pragma unroll
                    for (int n = 0; n < 2; ++n) acc[a][b][m][n] = (f32x4){0.f, 0.f, 0.f, 0.f};
        cur = nxt; cA = nA; cB = nB; ++ui;
    }
    PG8_WAIT_V(0);
    if (wr == 0) PG8_BAR;
    PG8_BAR;
#undef PG8_SA
#undef PG8_SB
#undef PG8_STAGE
#undef PG8_LDA
#undef PG8_LDB
#undef PG8_MMA
#undef PG8_WAIT_V
#undef PG8_WAIT_L
#undef PG8_BAR
#undef PG8_SCHED
}
}
typedef f32x4 AccT[2][2][4][2];

struct EpiInProj {
    bf16_t *segA, *segB, *gates; float* dtv; const float* dtbias; int dry;
    __device__ __forceinline__ void operator()(const AccT& acc, const pg8::Unit& u, int wr, int wc, int fr, int fq) const {
        if (dry & 4) return;
        const int pn = u.pn, row0 = u.pm * 256 + wr * 64 + fr;
        {
            bf16_t* base; int ld, colt, act;
            if (pn < 10) { base = segA; ld = LDA_SEG; colt = pn * 256; act = 0; }
            else if (pn < 20) { base = segB; ld = LDA_SEG; colt = (pn - 10) * 256; act = 0; }
            else { base = gates; ld = 2048; colt = (pn - 20) * 256; act = 2; }
            const int col0 = colt + wc * 32 + 8 * fq;
#pragma unroll
            for (int ai = 0; ai < 2; ++ai)
#pragma unroll
                for (int m = 0; m < 4; ++m) { bf16_t* rowp = base + (size_t)(row0 + ai * 128 + m * 16) * ld + col0;
#pragma unroll
                    for (int bj = 0; bj < 2; ++bj) { f32x4 v0 = acc[ai][bj][m][0], v1 = acc[ai][bj][m][1];
                        if (act == 1) {
#pragma unroll
                            for (int j = 0; j < 4; ++j) { v0[j] = siluf_(v0[j]); v1[j] = siluf_(v1[j]); } }
                        if (act == 2) {
#pragma unroll
                            for (int j = 0; j < 4; ++j) { v0[j] = sigmoidf_(v0[j]); v1[j] = sigmoidf_(v1[j]); } }
                        u32x4 w; w.x = pk2(v0[0], v0[1]); w.y = pk2(v0[2], v0[3]); w.z = pk2(v1[0], v1[1]); w.w = pk2(v1[2], v1[3]);
                        *(u32x4*)(rowp + bj * 128) = w; } }
        }
    }
};
struct EpiGlu {
    bf16_t* segA; const float* bglu;
    __device__ __forceinline__ void operator()(const AccT& acc, const pg8::Unit& u, int wr, int wc, int fr, int fq) const {
        const int row0 = u.pm * 256 + wr * 64 + fr, col0 = u.pn * 256 + wc * 32 + 8 * fq;
        f32x4 bb[2][2];
#pragma unroll
        for (int bj = 0; bj < 2; ++bj) { bb[bj][0] = *(const f32x4*)(bglu + col0 + bj * 128); bb[bj][1] = *(const f32x4*)(bglu + col0 + bj * 128 + 4); }
#pragma unroll
        for (int ai = 0; ai < 2; ++ai) {
            u32x4 yw[4][2], zw[4][2];
#pragma unroll
            for (int m = 0; m < 4; ++m)
#pragma unroll
                for (int bj = 0; bj < 2; ++bj) { const bf16_t* rowp = segA + (size_t)(row0 + ai * 128 + m * 16) * LDA_SEG + col0 + bj * 128; yw[m][bj] = *(const u32x4*)rowp; zw[m][bj] = *(const u32x4*)(rowp + 512); }
#pragma unroll
            for (int m = 0; m < 4; ++m)
#pragma unroll
                for (int bj = 0; bj < 2; ++bj) { bf16_t* rowp = segA + (size_t)(row0 + ai * 128 + m * 16) * LDA_SEG + col0 + bj * 128;
                    float y[8], z[8], o[8]; unpack8(yw[m][bj], y); unpack8(zw[m][bj], z);
#pragma unroll
                    for (int j = 0; j < 4; ++j) { o[j] = y[j] * sigmoidf_(acc[ai][bj][m][0][j] + bb[bj][0][j]) * siluf_(z[j]); o[4 + j] = y[4 + j] * sigmoidf_(acc[ai][bj][m][1][j] + bb[bj][1][j]) * siluf_(z[4 + j]); }
                    *(u32x4*)(rowp + 512) = pack8(o); }
            asm volatile("" ::: "memory"); }
    }
};
template <int MODE> struct EpiMerge {
    bf16_t* dst; const bf16_t* gates; const bf16_t* m5;
    __device__ __forceinline__ void operator()(const AccT& acc, const pg8::Unit& u, int wr, int wc, int fr, int fq) const {
        const int row0 = u.pm * 256 + wr * 64 + fr, col0 = u.pn * 256 + wc * 32 + 8 * fq;
#pragma unroll
        for (int ai = 0; ai < 2; ++ai) {
            u32x4 gw[4][2], mw[4][2];
            if (MODE != 2) {
#pragma unroll
                for (int m = 0; m < 4; ++m)
#pragma unroll
                    for (int bj = 0; bj < 2; ++bj) { const size_t r = (size_t)(row0 + ai * 128 + m * 16); const int c = col0 + bj * 128;
                        gw[m][bj] = *(const u32x4*)(gates + r * 2048 + (MODE == 1 ? 1024 : 0) + c); if (MODE == 1) mw[m][bj] = *(const u32x4*)(m5 + r * 1024 + c); } }
#pragma unroll
            for (int m = 0; m < 4; ++m)
#pragma unroll
                for (int bj = 0; bj < 2; ++bj) { const size_t r = (size_t)(row0 + ai * 128 + m * 16); const int c = col0 + bj * 128;
                    float o[8];
#pragma unroll
                    for (int j = 0; j < 4; ++j) { o[j] = acc[ai][bj][m][0][j]; o[4 + j] = acc[ai][bj][m][1][j]; }
                    if (MODE == 0) { float gt[8]; unpack8(gw[m][bj], gt);
#pragma unroll
                        for (int j = 0; j < 8; ++j) o[j] *= gt[j]; }
                    if (MODE == 1) { float gt[8], mm[8]; unpack8(gw[m][bj], gt); unpack8(mw[m][bj], mm);
#pragma unroll
                        for (int j = 0; j < 8; ++j) o[j] = mm[j] + gt[j] * o[j]; }
                    *(u32x4*)(dst + r * 1024 + c) = pack8(o); }
            asm volatile("" ::: "memory"); }
    }
};
struct EpiOut {
    const float* x; bf16_t* hbf; float* ss;
    __device__ __forceinline__ void operator()(const AccT& acc, const pg8::Unit& u, int wr, int wc, int fr, int fq) const {
        const int row0 = u.pm * 256 + wr * 64 + fr, col0 = u.pn * 256 + wc * 32 + 8 * fq;
#pragma unroll
        for (int ai = 0; ai < 2; ++ai) {
            f32x4 xv[4][2][2];
#pragma unroll
            for (int m = 0; m < 4; ++m)
#pragma unroll
                for (int bj = 0; bj < 2; ++bj) { const float* xp = x + (size_t)(row0 + ai * 128 + m * 16) * 1024 + col0 + bj * 128; xv[m][bj][0] = *(const f32x4*)xp; xv[m][bj][1] = *(const f32x4*)(xp + 4); }
#pragma unroll
            for (int m = 0; m < 4; ++m) { const size_t r = (size_t)(row0 + ai * 128 + m * 16); float s = 0.f;
#pragma unroll
                for (int bj = 0; bj < 2; ++bj) { const int c = col0 + bj * 128;
                    const f32x4 h0 = xv[m][bj][0] + acc[ai][bj][m][0], h1 = xv[m][bj][1] + acc[ai][bj][m][1];
                    u32x4 w; w.x = pk2(h0[0], h0[1]); w.y = pk2(h0[2], h0[3]); w.z = pk2(h1[0], h1[1]); w.w = pk2(h1[2], h1[3]);
                    *(u32x4*)(hbf + r * 1024 + c) = w;
#pragma unroll
                    for (int j = 0; j < 4; ++j) s += h0[j] * h0[j] + h1[j] * h1[j]; }
                s += __shfl_xor(s, 16); s += __shfl_xor(s, 32);
                if (fq == 0) ss[r * 16 + u.pn * 4 + wc] = s; }
            asm volatile("" ::: "memory"); }
    }
};
struct EpiPle {
    const bf16_t* h1bf; bf16_t* h2bf; const bf16_t* plep; const float* ss1; float* ss2;
    __device__ __forceinline__ void operator()(const AccT& acc, const pg8::Unit& u, int wr, int wc, int fr, int fq) const {
        const int row0 = u.pm * 256 + wr * 64 + fr, col0 = u.pn * 256 + wc * 32 + 8 * fq;
#pragma unroll
        for (int ai = 0; ai < 2; ++ai)
#pragma unroll
            for (int mp = 0; mp < 2; ++mp) {
                f32x4 q[2][4]; u32x4 pw[2][2], hw[2][2];
#pragma unroll
                for (int mm = 0; mm < 2; ++mm) { const size_t r = (size_t)(row0 + ai * 128 + (2 * mp + mm) * 16);
#pragma unroll
                    for (int k = 0; k < 4; ++k) q[mm][k] = *(const f32x4*)(ss1 + r * 16 + 4 * k);
#pragma unroll
                    for (int bj = 0; bj < 2; ++bj) { const size_t o = r * 1024 + col0 + bj * 128; pw[mm][bj] = *(const u32x4*)(plep + o); hw[mm][bj] = *(const u32x4*)(h1bf + o); } }
#pragma unroll
                for (int mm = 0; mm < 2; ++mm) { const int m = 2 * mp + mm; const size_t r = (size_t)(row0 + ai * 128 + m * 16); float s = 0.f;
                    const f32x4 qs = (q[mm][0] + q[mm][1]) + (q[mm][2] + q[mm][3]);
                    const float rstd = rsqrtf(((qs[0] + qs[1]) + (qs[2] + qs[3])) * (1.0f / 1024.0f) + 1e-6f);
#pragma unroll
                    for (int bj = 0; bj < 2; ++bj) { const int c = col0 + bj * 128;
                        float pp[8], hh[8]; unpack8(pw[mm][bj], pp); unpack8(hw[mm][bj], hh);
#pragma unroll
                        for (int j = 0; j < 4; ++j) { hh[j] += sigmoidf_(rstd * acc[ai][bj][m][0][j]) * pp[j]; hh[4 + j] += sigmoidf_(rstd * acc[ai][bj][m][1][j]) * pp[4 + j]; }
                        *(u32x4*)(h2bf + r * 1024 + c) = pack8(hh);
#pragma unroll
                        for (int j = 0; j < 8; ++j) s += hh[j] * hh[j]; }
                    s += __shfl_xor(s, 16); s += __shfl_xor(s, 32);
                    if (fq == 0) ss2[r * 16 + u.pn * 4 + wc] = s; }
                asm volatile("" ::: "memory"); }
    }
};

template <int MODE>
__device__ __forceinline__ void xpose_tiles(const float* __restrict__ src, int ldn, int K, bf16_t* __restrict__ dst, int Ndst, const float* __restrict__ kscale, LAS float* tile, int wg, int nwg) {
    const int nkt = K / 64, ntile = nkt * (Ndst / 64);
    for (int t = wg; t < ntile; t += nwg) {
        const int n0 = (t / nkt) * 64, k0 = (t % nkt) * 64;
        { const int r = threadIdx.x >> 4, c4 = (threadIdx.x & 15) * 4;
#pragma unroll
          for (int i = 0; i < 2; ++i) { const int k = k0 + r + 32 * i, n = n0 + c4; int sc = n;
              if (MODE == 1) sc = n < 5120 ? n : n + 24;
              if (MODE == 2) sc = n < 24 ? 5120 + n : -1;
              f32x4 v = (f32x4){0.f, 0.f, 0.f, 0.f};
              if (sc >= 0) v = *(const f32x4*)(src + (size_t)k * ldn + sc);
              if (kscale) v *= kscale[k];
              LAS float* tp = tile + (r + 32 * i) * 65 + c4; tp[0] = v[0]; tp[1] = v[1]; tp[2] = v[2]; tp[3] = v[3]; } }
        __syncthreads();
        { const int n = threadIdx.x >> 3, k8 = (threadIdx.x & 7) * 8; float f[8];
#pragma unroll
          for (int j = 0; j < 8; ++j) f[j] = tile[(k8 + j) * 65 + n];
          *(u32x4*)(dst + (size_t)(n0 + n) * K + k0 + k8) = pack8(f); }
        __syncthreads();
    }
}

__device__ __forceinline__ void dsincos(double x, double& s, double& c) {
    const double twopi = 6.283185307179586476925, hp = 1.5707963267948966192;
    x -= rint(x / twopi) * twopi;
    const double q = rint(x / hp); const double r = x - q * hp; const int qi = ((int)q) & 3;
    const double r2 = r * r;
    double sn = r * (1.0 + r2 * (-1.0 / 6 + r2 * (1.0 / 120 + r2 * (-1.0 / 5040 + r2 * (1.0 / 362880 + r2 * (-1.0 / 39916800 + r2 * (1.0 / 6227020800.0)))))));
    double cs = 1.0 + r2 * (-0.5 + r2 * (1.0 / 24 + r2 * (-1.0 / 720 + r2 * (1.0 / 40320 + r2 * (-1.0 / 3628800 + r2 * (1.0 / 479001600.0 + r2 * (-1.0 / 87178291200.0)))))));
    if (qi == 0) { s = sn; c = cs; } else if (qi == 1) { s = cs; c = -sn; } else if (qi == 2) { s = -sn; c = -cs; } else { s = -cs; c = sn; }
}
__device__ __forceinline__ void phase0(const Params& p, LAS unsigned char* lds) {
    const int tid = threadIdx.x, lane = tid & 63, gw = blockIdx.x * 8 + (tid >> 6), nw = gridDim.x * 8;
    bf16_t* xn = (bf16_t*)(p.ws + OFF_XN);
    for (int row0 = gw * 4; row0 < T_TOK; row0 += nw * 4) {
        f32x4 v[4][4]; float ss[4];
#pragma unroll
        for (int rr = 0; rr < 4; ++rr) { const f32x4* xr = (const f32x4*)(p.x + (size_t)(row0 + rr) * DM);
#pragma unroll
            for (int i = 0; i < 4; ++i) v[rr][i] = xr[lane + 64 * i]; }
#pragma unroll
        for (int rr = 0; rr < 4; ++rr) { float a = 0.f;
#pragma unroll
            for (int i = 0; i < 4; ++i) a += (v[rr][i][0] * v[rr][i][0] + v[rr][i][1] * v[rr][i][1]) + (v[rr][i][2] * v[rr][i][2] + v[rr][i][3] * v[rr][i][3]);
            ss[rr] = rsqrtf(wave_sum(a) * (1.0f / 1024.0f) + 1e-6f); }
#pragma unroll
        for (int i = 0; i < 4; ++i) { const f32x4 w = ((const f32x4*)p.norm_w)[lane + 64 * i];
#pragma unroll
            for (int rr = 0; rr < 4; ++rr) { const float r = ss[rr]; u32x2 o; o.x = pk2(v[rr][i][0] * r * w[0], v[rr][i][1] * r * w[1]); o.y = pk2(v[rr][i][2] * r * w[2], v[rr][i][3] * r * w[3]);
                *(u32x2*)(xn + (size_t)(row0 + rr) * DM + 4 * (lane + 64 * i)) = o; } }
    }
    xpose_tiles<1>(p.w_in, 7192, 1024, (bf16_t*)(p.ws + OFF_WIN), N_INP, nullptr, (LAS float*)lds, blockIdx.x, gridDim.x);
    xpose_tiles<2>(p.w_in, 7192, 1024, (bf16_t*)(p.ws + OFF_WDT), 64, nullptr, (LAS float*)lds, blockIdx.x, gridDim.x);
    xpose_tiles<0>(p.wglu, 512, 512, (bf16_t*)(p.ws + OFF_WGLU), 512, nullptr, (LAS float*)lds, blockIdx.x, gridDim.x);
    for (int gt = gw; gt < 2048; gt += nw) {
        const int g = gt >> 6, pp = gt & 63;
        const double step = exp((double)p.logstep[g]), ar = p.a_re[gt], ai = p.a_im[gt];
        const double mag = exp(ar * step); double sn, cs; dsincos(ai * step, sn, cs);
        const double lr = mag * cs, li = mag * sn, den = ar * ar + ai * ai, nr = lr - 1.0, ni = li;
        const double fre = (nr * ar + ni * ai) / den, fim = (ni * ar - nr * ai) / den;
        double pr = lr, pi = li;
#pragma unroll
        for (int i = 0; i < 7; ++i) { const double t = pr * pr - pi * pi; pi = 2.0 * pr * pi; pr = t; }
        if (lane == 0) { float* lam = (float*)(p.ws + OFF_LAM); float* lamL = (float*)(p.ws + OFF_LAML);
            lam[gt * 2] = (float)lr; lam[gt * 2 + 1] = (float)li; lamL[gt * 2] = (float)pr; lamL[gt * 2 + 1] = (float)pi; }
        bf16_t* bbt = (bf16_t*)(p.ws + OFF_BBT) + (size_t)g * 128 * 32; bf16_t* cwt = (bf16_t*)(p.ws + OFF_CWT) + (size_t)g * 16 * 128;
        if (lane < 16) { const int h = lane;
            const double br = p.b_re[gt * 16 + h], bi = p.b_im[gt * 16 + h];
            bbt[pp * 32 + h] = (bf16_t)(pk2((float)(fre * br - fim * bi), 0.f) & 0xffffu);
            bbt[(64 + pp) * 32 + h] = (bf16_t)(pk2((float)(fre * bi + fim * br), 0.f) & 0xffffu);
            cwt[h * 128 + pp] = (bf16_t)(pk2(p.c_re[(g * 16 + h) * 64 + pp], 0.f) & 0xffffu);
            cwt[h * 128 + 64 + pp] = (bf16_t)(pk2(-p.c_im[(g * 16 + h) * 64 + pp], 0.f) & 0xffffu);
        } else if (lane < 32) { bbt[pp * 32 + lane] = 0; bbt[(64 + pp) * 32 + lane] = 0; }
    }
}

template <int NCH> struct ConvMap { static constexpr int NOCT = NCH / 8, RUNS = 512 / NOCT, RL = 128 / RUNS; };
__device__ __forceinline__ void conv_load(const Params& p, int b, int c, int ch0, u32x4 (&raw)[7]) {
    const int co = threadIdx.x & 15, t0 = (threadIdx.x >> 4) * 4, ch = ch0 + co * 8;
    const bf16_t* segB = (const bf16_t*)(p.ws + OFF_SEGB);
#pragma unroll
    for (int i = 0; i < 7; ++i) { const int l = c * CH + t0 - 3 + i;
        raw[i] = (u32x4){0u, 0u, 0u, 0u};
        if (l >= 0) raw[i] = *(const u32x4*)(segB + (size_t)(b * SEQ + l) * LDA_SEG + ch); }
}
constexpr int CW_OFF = 112640;
__device__ __forceinline__ void conv_fill(const Params& p, LAS unsigned char* lds, int g) {
    LAS float* cw = (LAS float*)(lds + CW_OFF);
    for (int idx = threadIdx.x; idx < 5 * 5 * 128; idx += 512) { const int tile = idx / 640, k = (idx % 640) >> 7, ch = idx & 127;
        const int cb = tile < 3 ? (g * 6 + 2 * tile) * 64 : (tile == 3 ? 1536 + g * 128 : 2048 + g * 128);
        cw[idx] = k < 4 ? p.convw[k * 2560 + cb + ch] : p.convb[cb + ch]; }
    __syncthreads();
}
__device__ __forceinline__ void conv_compute(const LAS float* cwt  , const u32x4 (&raw)[7], float (&o)[4][8], int& t0, int& co) {
    co = threadIdx.x & 15; t0 = (threadIdx.x >> 4) * 4;
    float xr[7][8];
#pragma unroll
    for (int i = 0; i < 7; ++i) unpack8(raw[i], xr[i]);
    float cb[8];
    { const f32x4 b0 = *(const LAS f32x4*)(cwt + 4 * 128 + co * 8), b1 = *(const LAS f32x4*)(cwt + 4 * 128 + co * 8 + 4);
#pragma unroll
      for (int j = 0; j < 4; ++j) { cb[j] = b0[j]; cb[4 + j] = b1[j]; } }
#pragma unroll
    for (int i = 0; i < 4; ++i)
#pragma unroll
        for (int e = 0; e < 8; ++e) o[i][e] = cb[e];
#pragma unroll
    for (int k = 0; k < 4; ++k) { const f32x4 w0 = *(const LAS f32x4*)(cwt + k * 128 + co * 8), w1 = *(const LAS f32x4*)(cwt + k * 128 + co * 8 + 4);
#pragma unroll
        for (int i = 0; i < 4; ++i) {
#pragma unroll
            for (int j = 0; j < 4; ++j) { o[i][j] += w0[j] * xr[i + k][j]; o[i][4 + j] += w1[j] * xr[i + k][4 + j]; } } }
#pragma unroll
    for (int i = 0; i < 4; ++i)
#pragma unroll
        for (int e = 0; e < 8; ++e) o[i][e] = siluf_(o[i][e]);
}

constexpr int LP = 136;
__device__ __forceinline__ int tsw_w(int row, int t0) { return row * LP + ((((t0 >> 3) ^ (row >> 3)) & 15) << 3) + (t0 & 7); }
__device__ __forceinline__ int tsw_r(int row, int kb) { return row * LP + (((kb ^ (row >> 3)) & 15) << 3); }
__device__ __forceinline__ void ssd_acum(const Params& p, int b, int c, int g, LAS float* acum, LAS float* dts) {
    const int wid = threadIdx.x >> 6, lane = threadIdx.x & 63;
    if (wid < 6) {
        const int h = g * 6 + wid; const float A = -__expf(p.alog[h]);
        const float* dtv = (const float*)(p.ws + OFF_DTV) + (size_t)(b * SEQ + c * CH) * 24 + h;
        const float v0 = dtv[(2 * lane) * 24], v1 = dtv[(2 * lane + 1) * 24];
        const float d0 = v0 * A, d1 = v1 * A; float s = d0 + d1, inc = s;
#pragma unroll
        for (int o = 1; o < 64; o <<= 1) { const float t = __shfl_up(inc, o); if (lane >= o) inc += t; }
        const float ex = inc - s;
        acum[wid * 128 + 2 * lane] = ex + d0; acum[wid * 128 + 2 * lane + 1] = ex + d0 + d1;
        dts[wid * 128 + 2 * lane] = v0; dts[wid * 128 + 2 * lane + 1] = v1;
    }
}

__device__ __forceinline__ void ssd_states_item(const Params& p, LAS unsigned char* lds, int item) {
    const int g = item & 3, c = (item >> 2) & 15, b = item >> 6;
    const int tid = threadIdx.x, wid = tid >> 6, lane = tid & 63, fr = lane & 15, fq = lane >> 4;
    LAS bf16_t* BsT = (LAS bf16_t*)lds;
    LAS bf16_t* XdT = (LAS bf16_t*)(lds + 34816);
    LAS float* acum = (LAS float*)(lds + 69632);
    LAS float* dts = (LAS float*)(lds + 72704);
    u32x4 rawA[7], rawB[7];
    conv_load(p, b, c, 1536 + g * 128, rawA);
    conv_load(p, b, c, (g * 6) * 64, rawB);
    ssd_acum(p, b, c, g, acum, dts);
    { float o[4][8]; int t0, co; conv_compute((const LAS float*)(lds + CW_OFF) + 3 * 640, rawA, o, t0, co);
#pragma unroll
      for (int e = 0; e < 8; ++e) { u32x2 w; w.x = pk2(o[0][e], o[1][e]); w.y = pk2(o[2][e], o[3][e]); *(LAS u32x2*)(BsT + tsw_w(co * 8 + e, t0)) = w; } }
    __syncthreads();
    bf16_t* states = (bf16_t*)(p.ws + OFF_STATES);
#pragma unroll 1
    for (int hp = 0; hp < 3; ++hp) {
        { float o[4][8]; int t0, co; conv_compute((const LAS float*)(lds + CW_OFF) + hp * 640, rawB, o, t0, co);
          if (hp < 2) conv_load(p, b, c, (g * 6 + 2 * hp + 2) * 64, rawB);
          const int hl = 2 * hp + (co >> 3); const float alast = acum[hl * 128 + 127]; float sc[4];
#pragma unroll
          for (int i = 0; i < 4; ++i) sc[i] = dts[hl * 128 + t0 + i] * __expf(alast - acum[hl * 128 + t0 + i]);
#pragma unroll
          for (int e = 0; e < 8; ++e) { u32x2 w; w.x = pk2(o[0][e] * sc[0], o[1][e] * sc[1]); w.y = pk2(o[2][e] * sc[2], o[3][e] * sc[3]); *(LAS u32x2*)(XdT + tsw_w(co * 8 + e, t0)) = w; } }
        __syncthreads();
        f32x4 acc[8];
#pragma unroll
        for (int n = 0; n < 8; ++n) acc[n] = (f32x4){0.f, 0.f, 0.f, 0.f};
#pragma unroll
        for (int kk = 0; kk < 4; ++kk) { const bf16x8 xf = *(const LAS bf16x8*)(XdT + tsw_r(wid * 16 + fr, kk * 4 + fq));
#pragma unroll
            for (int n = 0; n < 8; ++n) { const bf16x8 bf = *(const LAS bf16x8*)(BsT + tsw_r(n * 16 + fr, kk * 4 + fq)); acc[n] = __builtin_amdgcn_mfma_f32_16x16x32_bf16(bf, xf, acc[n], 0, 0, 0); } }
        const int h = g * 6 + 2 * hp + (wid >> 2), prow = (wid & 3) * 16 + fr;
        bf16_t* dst = states + ((size_t)((b * NCHUNK + c) * 24 + h) * 64 + prow) * 128 + 4 * fq;
#pragma unroll
        for (int n = 0; n < 8; ++n) { u32x2 w; w.x = pk2(acc[n][0], acc[n][1]); w.y = pk2(acc[n][2], acc[n][3]); *(u32x2*)(dst + n * 16) = w; }
        __syncthreads();
    }
    if (tid < 6) ((float*)(p.ws + OFF_CDEC))[(b * NCHUNK + c) * 24 + g * 6 + tid] = __expf(acum[tid * 128 + 127]);
    __syncthreads();
}

__device__ __forceinline__ void ssd_prefix(const Params& p) {
    bf16_t* states = (bf16_t*)(p.ws + OFF_STATES); const float* cdec = (const float*)(p.ws + OFF_CDEC);
    const int nthr = gridDim.x * 512;
    for (int v = blockIdx.x * 512 + threadIdx.x; v < NBATCH * 24 * 1024; v += nthr) {
        const int bh = v >> 10, e = v & 1023, b = bh / 24, h = bh % 24;
        u32x4 s[NCHUNK];
#pragma unroll
        for (int c = 0; c < NCHUNK; ++c) s[c] = __builtin_nontemporal_load((const u32x4*)(states + (size_t)((b * NCHUNK + c) * 24 + h) * 8192 + e * 8));
        float prev[8];
#pragma unroll
        for (int j = 0; j < 8; ++j) prev[j] = 0.f;
#pragma unroll
        for (int c = 0; c < NCHUNK; ++c) {
            *(u32x4*)(states + (size_t)((b * NCHUNK + c) * 24 + h) * 8192 + e * 8) = pack8(prev);
            const float d = cdec[(b * NCHUNK + c) * 24 + h]; float f[8]; unpack8(s[c], f);
#pragma unroll
            for (int j = 0; j < 8; ++j) prev[j] = prev[j] * d + f[j];
        }
    }
}

__device__ __forceinline__ void ssd_out_item(const Params& p, LAS unsigned char* lds, int item) {
    const int g = item & 3, c = (item >> 2) & 15, b = item >> 6;
    const int tid = threadIdx.x, wid = tid >> 6, lane = tid & 63, fr = lane & 15, fq = lane >> 4;
    LAS bf16_t* Cs = (LAS bf16_t*)lds;
    LAS bf16_t* Bs = (LAS bf16_t*)(lds + 34816);
    LAS bf16_t* XT = (LAS bf16_t*)(lds + 69632);
    LAS float* acum = (LAS float*)(lds + 104448);
    LAS float* dts = (LAS float*)(lds + 107520);
    LAS float* red = (LAS float*)(lds + 110592);
    const size_t tok0 = (size_t)b * SEQ + c * CH;
    u32x4 rawA[7], rawB[7];
    conv_load(p, b, c, 2048 + g * 128, rawA);
    conv_load(p, b, c, 1536 + g * 128, rawB);
    ssd_acum(p, b, c, g, acum, dts);
    { float o[4][8]; int t0, co; conv_compute((const LAS float*)(lds + CW_OFF) + 4 * 640, rawA, o, t0, co);
#pragma unroll
      for (int i = 0; i < 4; ++i) *(LAS u32x4*)(Cs + (t0 + i) * LP + co * 8) = pack8(o[i]); }
    conv_load(p, b, c, (g * 6) * 64, rawA);
    { float o[4][8]; int t0, co; conv_compute((const LAS float*)(lds + CW_OFF) + 3 * 640, rawB, o, t0, co);
#pragma unroll
      for (int i = 0; i < 4; ++i) *(LAS u32x4*)(Bs + (t0 + i) * LP + co * 8) = pack8(o[i]); }
    __syncthreads();
    LAS float* vtab = (LAS float*)(lds + 125440);
    for (int idx = tid; idx < 6 * 128; idx += 512) vtab[idx] = __expf(acum[idx | 15] - acum[idx]) * dts[idx];
    f32x4 S[8];
#pragma unroll
    for (int st = 0; st < 8; ++st) S[st] = (f32x4){0.f, 0.f, 0.f, 0.f};
#pragma unroll
    for (int kk = 0; kk < 4; ++kk) { const bf16x8 cf = *(const LAS bf16x8*)(Cs + (wid * 16 + fr) * LP + kk * 32 + fq * 8);
#pragma unroll
        for (int st = 0; st < 8; ++st) if (st <= wid) { const bf16x8 bf = *(const LAS bf16x8*)(Bs + (st * 16 + fr) * LP + kk * 32 + fq * 8); S[st] = __builtin_amdgcn_mfma_f32_16x16x32_bf16(bf, cf, S[st], 0, 0, 0); } }
    __syncthreads();
    LAS bf16_t* Pb = Bs;
    const int half = wid >> 2, pt = wid & 3;
    float ssq[4] = {0.f, 0.f, 0.f, 0.f};
    const bf16_t* states = (const bf16_t*)(p.ws + OFF_STATES);
    bf16_t* segA = (bf16_t*)(p.ws + OFF_SEGA);
    bf16x8 pfn[4];
    { const bf16_t* pr = states + ((size_t)((b * NCHUNK + c) * 24 + g * 6) * 64 + pt * 16 + fr) * 128 + fq * 8;
#pragma unroll
      for (int kk = 0; kk < 4; ++kk) pfn[kk] = *(const bf16x8*)(pr + kk * 32);
 }
#pragma unroll 1
    for (int j = 0; j < 6; ++j) {
        const int hp = j >> 1, hs = j & 1, h = g * 6 + j;
        if (hs == 0) { float o[4][8]; int t0, co; conv_compute((const LAS float*)(lds + CW_OFF) + hp * 640, rawA, o, t0, co);
          if (hp < 2) conv_load(p, b, c, (g * 6 + 2 * hp + 2) * 64, rawA);
#pragma unroll
          for (int e = 0; e < 8; ++e) { u32x2 w; w.x = pk2(o[0][e], o[1][e]); w.y = pk2(o[2][e], o[3][e]); *(LAS u32x2*)(XT + tsw_w(co * 8 + e, t0)) = w; } }
        {
            bf16x8 pf[4]; u32x2 zw4[4];
#pragma unroll
            for (int kk = 0; kk < 4; ++kk) pf[kk] = pfn[kk];
#pragma unroll
            for (int q = 0; q < 4; ++q) { const int lt = half == 0 ? (q == 0 ? 0 : (q == 1 ? 3 : (q == 2 ? 4 : 7))) : (q == 0 ? 1 : (q == 1 ? 2 : (q == 2 ? 5 : 6)));
                zw4[q] = *(const u32x2*)(segA + (tok0 + lt * 16 + fr) * LDA_SEG + 1024 + h * 64 + pt * 16 + 4 * fq); }
            if (j < 5) { const bf16_t* pr = states + ((size_t)((b * NCHUNK + c) * 24 + h + 1) * 64 + pt * 16 + fr) * 128 + fq * 8;
#pragma unroll
              for (int kk = 0; kk < 4; ++kk) pfn[kk] = *(const bf16x8*)(pr + kk * 32); }
            {
              const int l = wid * 16 + fr; const float al = acum[j * 128 + l], Dh = p.ssdd[h];
#pragma unroll
              for (int st = 0; st < 8; ++st) if (st <= (wid | 1)) { float v[4];
                  if (st < wid) {
                      const float uu = __expf(al - acum[j * 128 + st * 16 + 15]); const f32x4 v4 = *(const LAS f32x4*)(vtab + j * 128 + st * 16 + 4 * fq);
#pragma unroll
                      for (int jj = 0; jj < 4; ++jj) v[jj] = S[st][jj] * uu * v4[jj];
                  } else {
                      const f32x4 as4 = *(const LAS f32x4*)(acum + j * 128 + st * 16 + 4 * fq), ds4 = *(const LAS f32x4*)(dts + j * 128 + st * 16 + 4 * fq);
#pragma unroll
                      for (int jj = 0; jj < 4; ++jj) { const int sx = st * 16 + 4 * fq + jj; float t = 0.f;
                          if (sx <= l) t = S[st][jj] * __expf(al - as4[jj]) * ds4[jj];
                          if (sx == l) t += Dh; v[jj] = t; } }
                  u32x2 w; w.x = pk2(v[0], v[1]); w.y = pk2(v[2], v[3]); *(LAS u32x2*)(Pb + l * LP + st * 16 + 4 * fq) = w; } }
            __syncthreads();
            bf16x8 xf[4];
#pragma unroll
            for (int kk = 0; kk < 4; ++kk) xf[kk] = *(const LAS bf16x8*)(XT + tsw_r(hs * 64 + pt * 16 + fr, kk * 4 + fq));
            __builtin_amdgcn_s_setprio(1);
#pragma unroll
            for (int q = 0; q < 4; ++q) {
                const int lt = half == 0 ? (q == 0 ? 0 : (q == 1 ? 3 : (q == 2 ? 4 : 7))) : (q == 0 ? 1 : (q == 1 ? 2 : (q == 2 ? 5 : 6)));
                f32x4 ad = (f32x4){0.f, 0.f, 0.f, 0.f}, ao = (f32x4){0.f, 0.f, 0.f, 0.f};
#pragma unroll
                for (int kk = 0; kk < 4; ++kk) if (kk <= (lt >> 1)) { const bf16x8 pfr = *(const LAS bf16x8*)(Pb + (lt * 16 + fr) * LP + kk * 32 + fq * 8); ad = __builtin_amdgcn_mfma_f32_16x16x32_bf16(xf[kk], pfr, ad, 0, 0, 0); }
#pragma unroll
                for (int kk = 0; kk < 4; ++kk) { const bf16x8 cfr = *(const LAS bf16x8*)(Cs + (lt * 16 + fr) * LP + kk * 32 + fq * 8); ao = __builtin_amdgcn_mfma_f32_16x16x32_bf16(pf[kk], cfr, ao, 0, 0, 0); }
                const int l = lt * 16 + fr; const float ea = __expf(acum[j * 128 + l]);
                bf16_t* zp = segA + (tok0 + l) * LDA_SEG + 1024 + h * 64 + pt * 16 + 4 * fq;
                const u32x2 zw = zw4[q];
                const float y0 = (ad[0] + ea * ao[0]) * siluf_(bflo(zw.x)), y1 = (ad[1] + ea * ao[1]) * siluf_(bfhi(zw.x)), y2 = (ad[2] + ea * ao[2]) * siluf_(bflo(zw.y)), y3 = (ad[3] + ea * ao[3]) * siluf_(bfhi(zw.y));
                ssq[q] += (y0 * y0 + y1 * y1) + (y2 * y2 + y3 * y3);
                u32x2 yo; yo.x = pk2(y0, y1); yo.y = pk2(y2, y3); if (!(p.dry & 1)) *(u32x2*)zp = yo;
            }
            __builtin_amdgcn_s_setprio(0);
            __syncthreads();
        }
    }
#pragma unroll
    for (int q = 0; q < 4; ++q) { float s = ssq[q]; s += __shfl_xor(s, 16); s += __shfl_xor(s, 32); if (fq == 0) red[wid * 64 + q * 16 + fr] = s; }
    __syncthreads();
    float rstd[4];
#pragma unroll
    for (int q = 0; q < 4; ++q) { const int o = q * 16 + fr; const float tot = (red[(half * 4 + 0) * 64 + o] + red[(half * 4 + 1) * 64 + o]) + (red[(half * 4 + 2) * 64 + o] + red[(half * 4 + 3) * 64 + o]);
        rstd[q] = rsqrtf(tot * (1.0f / 384.0f) + 1e-6f); }
#pragma unroll
    for (int j = 0; j < 6; ++j) { const int h = g * 6 + j; const f32x4 nw = *(const f32x4*)(p.ssdnw + h * 64 + pt * 16 + 4 * fq);
#pragma unroll
        for (int q = 0; q < 4; ++q) {
            const int lt = half == 0 ? (q == 0 ? 0 : (q == 1 ? 3 : (q == 2 ? 4 : 7))) : (q == 0 ? 1 : (q == 1 ? 2 : (q == 2 ? 5 : 6)));
            const int l = lt * 16 + fr; bf16_t* zp = segA + (tok0 + l) * LDA_SEG + 1024 + h * 64 + pt * 16 + 4 * fq;
            const u32x2 w = *(const u32x2*)zp; u32x2 o;
            o.x = pk2(bflo(w.x) * rstd[q] * nw[0], bfhi(w.x) * rstd[q] * nw[1]); o.y = pk2(bflo(w.y) * rstd[q] * nw[2], bfhi(w.y) * rstd[q] * nw[3]);
            if (!(p.dry & 1)) *(u32x2*)zp = o; } }
    __syncthreads();
}

template <int PASS>
__device__ __forceinline__ void s5_wave_item(const Params& p, LAS float* wl  , int item) {
    const int g = item & 31, c = (item >> 5) & 15, b = item >> 9;
    const int lane = threadIdx.x & 63, fr = lane & 15, fq = lane >> 4;
    const size_t tok0 = (size_t)b * SEQ + c * CH;
    bf16_t* segA = (bf16_t*)(p.ws + OFF_SEGA);
    const float* lam = (const float*)(p.ws + OFF_LAM); const float lr = lam[(g * 64 + lane) * 2], li = lam[(g * 64 + lane) * 2 + 1];
    float* E = (float*)(p.ws + OFF_E);
    bf16x8 bbf[8];
    { const bf16_t* bbt = (const bf16_t*)(p.ws + OFF_BBT) + (size_t)g * 128 * 32;
#pragma unroll
      for (int n = 0; n < 8; ++n) bbf[n] = *(const bf16x8*)(bbt + (n * 16 + fr) * 32 + fq * 8); }
    float sr = 0.f, si = 0.f;
    bf16x8 cwf[4]; f32x4 dv = (f32x4){0.f, 0.f, 0.f, 0.f};
    if (PASS == 2) {
        const float* lamL = (const float*)(p.ws + OFF_LAML); const float Lr = lamL[(g * 64 + lane) * 2], Li = lamL[(g * 64 + lane) * 2 + 1];
        float er[15], ei[15];
#pragma unroll
        for (int cc = 0; cc < 15; ++cc) { er[cc] = 0.f; ei[cc] = 0.f; if (cc < c) { er[cc] = E[(size_t)((b * NCHUNK + cc) * 32 + g) * 128 + lane]; ei[cc] = E[(size_t)((b * NCHUNK + cc) * 32 + g) * 128 + 64 + lane]; } }
#pragma unroll
        for (int cc = 0; cc < 15; ++cc) if (cc < c) { const float nr = Lr * sr - Li * si + er[cc], ni = Lr * si + Li * sr + ei[cc]; sr = nr; si = ni; }
        const bf16_t* cwt = (const bf16_t*)(p.ws + OFF_CWT) + (size_t)g * 16 * 128;
#pragma unroll
        for (int kk = 0; kk < 4; ++kk) cwf[kk] = *(const bf16x8*)(cwt + fr * 128 + kk * 32 + fq * 8);
        dv = *(const f32x4*)(p.s5d + g * 16 + 4 * fq);
    }
    bf16x8 ufa[8]; u32x2 uwa[8];
#pragma unroll
    for (int bt = 0; bt < 8; ++bt) { ufa[bt] = (bf16x8){0, 0, 0, 0, 0, 0, 0, 0}; uwa[bt] = (u32x2){0u, 0u};
        if (fq < 2) ufa[bt] = *(const bf16x8*)(segA + (tok0 + bt * 16 + fr) * LDA_SEG + g * 16 + fq * 8);
        if (PASS == 2) uwa[bt] = *(const u32x2*)(segA + (tok0 + bt * 16 + fr) * LDA_SEG + g * 16 + 4 * fq); }
#pragma unroll
    for (int bt = 0; bt < 8; ++bt) {
        const size_t trow = tok0 + bt * 16 + fr;
        const bf16x8 uf = ufa[bt]; const u32x2 uw = uwa[bt];
        f32x4 bu[8];
#pragma unroll
        for (int n = 0; n < 8; ++n) { bu[n] = (f32x4){0.f, 0.f, 0.f, 0.f}; bu[n] = __builtin_amdgcn_mfma_f32_16x16x32_bf16(bbf[n], uf, bu[n], 0, 0, 0); }
        asm volatile("s_nop 15\n\ts_nop 15" : "+v"(bu[0]), "+v"(bu[1]), "+v"(bu[2]), "+v"(bu[3]), "+v"(bu[4]), "+v"(bu[5]), "+v"(bu[6]), "+v"(bu[7]));
#pragma unroll
        for (int n = 0; n < 8; ++n) *(LAS f32x4*)(wl + fr * 132 + n * 16 + 4 * fq) = bu[n];
        asm volatile("s_waitcnt lgkmcnt(0)" ::: "memory"); __builtin_amdgcn_wave_barrier();
        float br[16], bi[16];
#pragma unroll
        for (int t = 0; t < 16; ++t) { br[t] = wl[t * 132 + lane]; bi[t] = wl[t * 132 + 64 + lane]; }
#pragma unroll
        for (int t = 0; t < 16; ++t) { const float nr = lr * sr - li * si + br[t], ni = lr * si + li * sr + bi[t]; sr = nr; si = ni; br[t] = sr; bi[t] = si; }
        if (PASS == 2) {
#pragma unroll
            for (int t = 0; t < 16; ++t) { wl[t * 132 + lane] = br[t]; wl[t * 132 + 64 + lane] = bi[t]; } }
        if (PASS == 2) {
            asm volatile("s_waitcnt lgkmcnt(0)" ::: "memory"); __builtin_amdgcn_wave_barrier();
            f32x4 a = (f32x4){0.f, 0.f, 0.f, 0.f};
#pragma unroll
            for (int kk = 0; kk < 4; ++kk) { const f32x4 s0 = *(const LAS f32x4*)(wl + fr * 132 + kk * 32 + fq * 8), s1 = *(const LAS f32x4*)(wl + fr * 132 + kk * 32 + fq * 8 + 4);
                u32x4 w; w.x = pk2(s0[0], s0[1]); w.y = pk2(s0[2], s0[3]); w.z = pk2(s1[0], s1[1]); w.w = pk2(s1[2], s1[3]);
                bf16x8 sf; __builtin_memcpy(&sf, &w, 16);
                a = __builtin_amdgcn_mfma_f32_16x16x32_bf16(cwf[kk], sf, a, 0, 0, 0); }
            bf16_t* up = segA + trow * LDA_SEG + g * 16 + 4 * fq;
            const float y0 = geluf_(a[0] + dv[0] * bflo(uw.x)), y1 = geluf_(a[1] + dv[1] * bfhi(uw.x)), y2 = geluf_(a[2] + dv[2] * bflo(uw.y)), y3 = geluf_(a[3] + dv[3] * bfhi(uw.y));
            u32x2 o; o.x = pk2(y0, y1); o.y = pk2(y2, y3); if (!(p.dry & 2)) *(u32x2*)up = o;
            asm volatile("s_waitcnt lgkmcnt(0)" ::: "memory"); __builtin_amdgcn_wave_barrier();
        }
    }
    if (PASS == 1) { E[(size_t)((b * NCHUNK + c) * 32 + g) * 128 + lane] = sr; E[(size_t)((b * NCHUNK + c) * 32 + g) * 128 + 64 + lane] = si; }
}

#define XB_TMO      128
#define XB_XCNT(j)  (256  + 64 * (j))
#define XB_XSUB(j)  (1280 + 64 * (j))
#define XB_XGEN(j)  (2304 + 64 * (j))
#define XB_TOP      3328
#define XB_TOPGEN   3392
#define XCD_BAR_WORDS 3456
#define XB_SPIN_CAP (1u << 18)
__device__ __forceinline__ unsigned xb_ld(unsigned* p)              { return __hip_atomic_load(p, __ATOMIC_RELAXED, __HIP_MEMORY_SCOPE_AGENT); }
__device__ __forceinline__ unsigned xb_add(unsigned* p, unsigned v) { return __hip_atomic_fetch_add(p, v, __ATOMIC_RELAXED, __HIP_MEMORY_SCOPE_AGENT); }
__device__ __forceinline__ unsigned xb_xcc_id() { return (unsigned)__builtin_amdgcn_s_getreg((3 << 11) | 20) & 0xFu; }
#define XB_SPIN(cond, bar) do { unsigned _sp = 0; while (cond) { __builtin_amdgcn_s_sleep(1); \
    if ((++_sp & 255u) == 0u) { if (xb_ld(&(bar)[XB_TMO])) break; if (_sp > XB_SPIN_CAP) { atomicAdd(&(bar)[XB_TMO], 1u); break; } } } } while (0)
struct XcdBarrier { unsigned* bar; unsigned x; volatile LAS unsigned* st; };
__device__ __forceinline__ XcdBarrier xcd_barrier_post(unsigned* bar, volatile LAS unsigned* st) {
    XcdBarrier b; b.bar = bar; b.x = xb_xcc_id(); b.st = st;
    if (threadIdx.x == 0) (void)xb_add(&bar[XB_XCNT(b.x)], 1u);
    return b;
}
__device__ __forceinline__ void xcd_barrier_complete(unsigned* bar, unsigned x, unsigned& nloc, unsigned& nx) {
    const unsigned G = gridDim.x * gridDim.y * gridDim.z;
    unsigned sum, cnt, mine, sp = 0u;
    for (;;) {
        sum = 0u; cnt = 0u; mine = 0u;
#pragma unroll
        for (unsigned j = 0; j < 16; ++j) { const unsigned c = xb_ld(&bar[XB_XCNT(j)]); sum += c; cnt += (c > 0u) ? 1u : 0u; mine = (j == x) ? c : mine; }
        if (sum == G) break;
        __builtin_amdgcn_s_sleep(1);
        if ((++sp & 255u) == 0u) { if (xb_ld(&bar[XB_TMO])) break; if (sp > XB_SPIN_CAP) { atomicAdd(&bar[XB_TMO], 1u); break; } }
    }
    nloc = mine > 0u ? mine : 1u; nx = cnt > 0u ? cnt : 1u;
}
__device__ __forceinline__ void xcd_barrier(const XcdBarrier& b) {
    asm volatile("s_waitcnt vmcnt(0)" ::: "memory");
    __syncthreads();
    if (threadIdx.x == 0) {
        unsigned* bar = b.bar;
        __builtin_amdgcn_s_waitcnt(0);
        unsigned nloc = b.st[0], nx = b.st[1];
        if (nloc == 0u) { xcd_barrier_complete(bar, b.x, nloc, nx); b.st[0] = nloc; b.st[1] = nx; }
        const unsigned old = xb_add(&bar[XB_XSUB(b.x)], 1u);
        const unsigned gen = old / nloc;
        if (old + 1u == (gen + 1u) * nloc) {
            __builtin_amdgcn_fence(__ATOMIC_RELEASE, "agent");
            asm volatile("s_waitcnt vmcnt(0)" ::: "memory");
            const unsigned og = xb_add(&bar[XB_TOP], 1u);
            const unsigned tg = og / nx;
            if (og + 1u == (tg + 1u) * nx) xb_add(&bar[XB_TOPGEN], 1u);
            else XB_SPIN(xb_ld(&bar[XB_TOPGEN]) == tg, bar);
            __builtin_amdgcn_fence(__ATOMIC_ACQUIRE, "agent");
            xb_add(&bar[XB_XGEN(b.x)], 1u);
            asm volatile("s_waitcnt vmcnt(0)" ::: "memory");
        } else {
            XB_SPIN(xb_ld(&bar[XB_XGEN(b.x)]) == gen, bar);
            __builtin_amdgcn_fence(__ATOMIC_ACQUIRE, "agent");
            asm volatile("s_waitcnt vmcnt(0)" ::: "memory");
        }
    }
    __syncthreads();
}

__global__ void __launch_bounds__(512) mega(Params p) {
    extern __shared__ __attribute__((aligned(16))) unsigned char lds_raw[];
    LAS unsigned char* lds = (LAS unsigned char*)lds_raw;
    cg::grid_group grid = cg::this_grid();
    const int lo = p.ph_lo, hi = p.ph_hi, G = gridDim.x, wg = blockIdx.x, tid = threadIdx.x, wid = tid >> 6;
    unsigned char* ws = p.ws;
#ifndef ONLY
#define ONLY -1
#endif
#define IN(k) ((ONLY < 0 || ONLY == (k)) && lo <= (k) && (k) <= hi)
#define SEAM(k) do { if (lo <= (k) && (k) < hi) xcd_barrier(xb); } while (0)
    if (lo < 0) grid.sync();
    XcdBarrier xb; xb.bar = (unsigned*)(ws + OFF_BAR); xb.x = 0; xb.st = (volatile LAS unsigned*)(lds + 131072);
    if (lo < hi) {
        if (tid < 2) xb.st[tid] = 0u;
        __syncthreads();
        xb = xcd_barrier_post((unsigned*)(ws + OFF_BAR), (volatile LAS unsigned*)(lds + 131072));
    }
    if (IN(0)) phase0(p, lds);
    SEAM(0);
    if (IN(1)) {
        {
            const int lane = tid & 63, fr = lane & 15, fq = lane >> 4;
            const bf16_t* xn = (const bf16_t*)(ws + OFF_XN); const bf16_t* wdt = (const bf16_t*)(ws + OFF_WDT); float* dtv = (float*)(ws + OFF_DTV);
            for (int rt = wg * 8 + wid; rt < T_TOK / 16; rt += G * 8) {
                f32x4 a0 = (f32x4){0.f, 0.f, 0.f, 0.f}, a1 = a0;
                const bf16_t* xr = xn + (size_t)(rt * 16 + fr) * 1024 + fq * 8; const bf16_t* w0 = wdt + (size_t)fr * 1024 + fq * 8; const bf16_t* w1 = w0 + 16 * 1024;
#pragma unroll 8
                for (int kk = 0; kk < 32; ++kk) { const bf16x8 xa = *(const bf16x8*)(xr + kk * 32), b0 = *(const bf16x8*)(w0 + kk * 32), b1 = *(const bf16x8*)(w1 + kk * 32);
                    a0 = __builtin_amdgcn_mfma_f32_16x16x32_bf16(b0, xa, a0, 0, 0, 0); a1 = __builtin_amdgcn_mfma_f32_16x16x32_bf16(b1, xa, a1, 0, 0, 0); }
                float* dr = dtv + (size_t)(rt * 16 + fr) * 24 + 4 * fq; f32x4 o0, o1;
#pragma unroll
                for (int j = 0; j < 4; ++j) { o0[j] = softplusf_(a0[j] + p.dtbias[4 * fq + j]); o1[j] = softplusf_(a1[j] + p.dtbias[(16 + 4 * fq + j) % 24]); }
                *(f32x4*)dr = o0; if (fq < 2) *(f32x4*)(dr + 16) = o1;
            }
        }
        pg8::Gemm g{(const bf16_t*)(ws + OFF_XN), (const bf16_t*)(ws + OFF_WIN), 1024, 1024, T_TOK, N_INP, 1024}; pg8::StaticOrder S; S.init(T_TOK, N_INP, G, wg);
        EpiInProj E{(bf16_t*)(ws + OFF_SEGA), (bf16_t*)(ws + OFF_SEGB), (bf16_t*)p.out, (float*)(ws + OFF_DTV), p.dtbias, p.dry};
        pg8::gemm_phase(lds, g, S, E);
    }
    SEAM(1);
    if (IN(2)) {
        if (!(p.dry & 32)) for (int it = wg; it < 1024; it += G) { if (it == wg || (G & 3)) conv_fill(p, lds, it & 3); ssd_states_item(p, lds, it); }
        for (int it = wg * 8 + wid; it < 8192; it += G * 8) if (((it >> 5) & 15) != 15) s5_wave_item<1>(p, (LAS float*)(lds + wid * 8448), it);
    }
    SEAM(2);
    if (IN(3)) {
        const bool s5first = (wg & 1) != 0;
        if (!s5first) ssd_prefix(p);
        for (int it = wg * 8 + wid; it < 8192; it += G * 8) s5_wave_item<2>(p, (LAS float*)(lds + wid * 8448), it);
        if (s5first) ssd_prefix(p);
    }
    SEAM(3);
    if (IN(4)) {
#ifndef NO_SSD_OUT
        if (p.dry != 2) for (int it = wg; it < 1024; it += G) { if (it == wg || (G & 3)) conv_fill(p, lds, it & 3); ssd_out_item(p, lds, it); }
#endif
    }
    SEAM(4);
    if (IN(5)) {
        { pg8::Gemm g{(const bf16_t*)(ws + OFF_SEGA), (const bf16_t*)(ws + OFF_WGLU), LDA_SEG, 512, T_TOK, 512, 512}; pg8::StaticOrder S; S.init(T_TOK, 512, G, wg);
          EpiGlu E{(bf16_t*)(ws + OFF_SEGA), p.bglu}; pg8::gemm_phase(lds, g, S, E); }
        __syncthreads();
        xpose_tiles<0>(p.wbr5, 1024, 512, (bf16_t*)(ws + OFF_W5T), 1024, nullptr, (LAS float*)lds, wg, G);
        xpose_tiles<0>(p.wbrs, 1024, 1536, (bf16_t*)(ws + OFF_WSST), 1024, nullptr, (LAS float*)lds, wg, G);
        xpose_tiles<0>(p.wout, 1024, 1024, (bf16_t*)(ws + OFF_WOUTT), 1024, nullptr, (LAS float*)lds, wg, G);
        xpose_tiles<0>(p.wpg, 1024, 1024, (bf16_t*)(ws + OFF_WPGT), 1024, p.plenw, (LAS float*)lds, wg, G);
        xpose_tiles<0>(p.wpp, 1024, 256, (bf16_t*)(ws + OFF_WPPT), 1024, nullptr, (LAS float*)lds, wg, G);
        { bf16_t* pbf = (bf16_t*)(ws + OFF_PBF); const int nthr = G * 512;
          for (int v = wg * 512 + tid; v < T_TOK * 256 / 8; v += nthr) { const f32x4 a = *(const f32x4*)(p.p + (size_t)v * 8), bq = *(const f32x4*)(p.p + (size_t)v * 8 + 4);
              u32x4 w; w.x = pk2(a[0], a[1]); w.y = pk2(a[2], a[3]); w.z = pk2(bq[0], bq[1]); w.w = pk2(bq[2], bq[3]); *(u32x4*)(pbf + (size_t)v * 8) = w; } }
    }
    SEAM(5);
    if (IN(6)) {
        { pg8::Gemm g{(const bf16_t*)(ws + OFF_SEGA) + 512, (const bf16_t*)(ws + OFF_W5T), LDA_SEG, 512, T_TOK, 1024, 512}; pg8::StaticOrder S; S.init(T_TOK, 1024, G, wg);
          EpiMerge<0> E{(bf16_t*)(ws + OFF_M5), (const bf16_t*)p.out, nullptr}; pg8::gemm_phase(lds, g, S, E); }
        { pg8::Gemm g{(const bf16_t*)(ws + OFF_SEGA) + 1024, (const bf16_t*)(ws + OFF_WSST), LDA_SEG, 1536, T_TOK, 1024, 1536}; pg8::StaticOrder S; S.init(T_TOK, 1024, G, wg);
          EpiMerge<1> E{(bf16_t*)(ws + OFF_MERGED), (const bf16_t*)p.out, (const bf16_t*)(ws + OFF_M5)}; pg8::gemm_phase(lds, g, S, E); }
    }
    SEAM(6);
    if (IN(7)) {
        pg8::Gemm g{(const bf16_t*)(ws + OFF_MERGED), (const bf16_t*)(ws + OFF_WOUTT), 1024, 1024, T_TOK, 1024, 1024}; pg8::StaticOrder S; S.init(T_TOK, 1024, G, wg);
        EpiOut E{p.x, (bf16_t*)(ws + OFF_M5), (float*)(ws + OFF_SS1)}; pg8::gemm_phase(lds, g, S, E);
    }
    SEAM(7);
    if (IN(8)) {
        { pg8::Gemm g{(const bf16_t*)(ws + OFF_PBF), (const bf16_t*)(ws + OFF_WPPT), 256, 256, T_TOK, 1024, 256}; pg8::StaticOrder S; S.init(T_TOK, 1024, G, wg);
          EpiMerge<2> E{(bf16_t*)(ws + OFF_PLEP), nullptr, nullptr}; pg8::gemm_phase(lds, g, S, E); }
        { pg8::Gemm g{(const bf16_t*)(ws + OFF_M5), (const bf16_t*)(ws + OFF_WPGT), 1024, 1024, T_TOK, 1024, 1024}; pg8::StaticOrder S; S.init(T_TOK, 1024, G, wg);
          EpiPle E{(const bf16_t*)(ws + OFF_M5), (bf16_t*)(ws + OFF_SEGA), (const bf16_t*)(ws + OFF_PLEP), (const float*)(ws + OFF_SS1), (float*)(ws + OFF_SS2)}; pg8::gemm_phase(lds, g, S, E); }
    }
    SEAM(8);
    if (IN(9)) {
        const int lane = tid & 63; const float* ss2 = (const float*)(ws + OFF_SS2);
        for (int row0 = (wg * 8 + wid) * 2; row0 < T_TOK; row0 += G * 16) {
            u32x2 hw[2][4]; float r[2];
#pragma unroll
            for (int rr = 0; rr < 2; ++rr) { const u32x2* hp2 = (const u32x2*)((const bf16_t*)(ws + OFF_SEGA) + (size_t)(row0 + rr) * DM);
#pragma unroll
                for (int i = 0; i < 4; ++i) hw[rr][i] = __builtin_nontemporal_load(hp2 + lane + 64 * i);
                float s = lane < 16 ? ss2[(size_t)(row0 + rr) * 16 + lane] : 0.f; s = wave_sum(s); r[rr] = rsqrtf(s * (1.0f / 1024.0f) + 1e-6f); }
#pragma unroll
            for (int i = 0; i < 4; ++i) { const f32x4 w = ((const f32x4*)p.fnw)[lane + 64 * i];
#pragma unroll
                for (int rr = 0; rr < 2; ++rr) { f32x4 v; v[0] = bflo(hw[rr][i].x) * r[rr] * w[0]; v[1] = bfhi(hw[rr][i].x) * r[rr] * w[1]; v[2] = bflo(hw[rr][i].y) * r[rr] * w[2]; v[3] = bfhi(hw[rr][i].y) * r[rr] * w[3];
                    __builtin_nontemporal_store(v, (f32x4*)(p.out + (size_t)(row0 + rr) * DM) + lane + 64 * i); } }
        }
    }
#undef IN
#undef SEAM
}

#ifndef N_LAUNCH_MODE
#define N_LAUNCH_MODE 1
#endif
extern "C" void kernel_launch(void* const* d_in, const int* in_sizes, int n_in, void* d_out, int out_size, void* d_ws, size_t ws_size, hipStream_t stream) {
    static int grid = 0;
    if (grid == 0) {
        if (n_in != 27 || ws_size < WS_NEED) { fprintf(stderr, "kernel_launch: need 27 inputs and >= %zu bytes of workspace; got %d, %zu\n", (size_t)WS_NEED, n_in, ws_size); grid = -1; return; }
        int dev = 0, cus = 0, per_cu = 0;
        hipGetDevice(&dev); hipDeviceGetAttribute(&cus, hipDeviceAttributeMultiprocessorCount, dev);
        if (hipFuncSetAttribute((const void*)mega, hipFuncAttributeMaxDynamicSharedMemorySize, LDS_BYTES) != hipSuccess) { fprintf(stderr, "kernel_launch: hipFuncSetAttribute failed\n"); grid = -1; return; }
        if (hipOccupancyMaxActiveBlocksPerMultiprocessor(&per_cu, (const void*)mega, 512, LDS_BYTES) != hipSuccess || per_cu < 1) { fprintf(stderr, "kernel_launch: occupancy query says %d blocks per CU\n", per_cu); per_cu = 1; }
        (void)hipGetLastError();
        grid = cus;
    }
    if (grid < 0) return;
    Params p{};
    const float** pp = (const float**)&p;
    for (int i = 0; i < 27; ++i) pp[i] = (const float*)d_in[i];
    p.out = (float*)d_out; p.ws = (unsigned char*)d_ws;
#if N_LAUNCH_MODE == 1
    hipMemsetAsync((unsigned char*)d_ws + OFF_BAR, 0, XCD_BAR_WORDS * 4, stream);
    p.ph_lo = 0; p.ph_hi = 9;
    void* args[] = {&p};
    hipError_t e = hipLaunchCooperativeKernel((const void*)mega, dim3(grid), dim3(512), args, LDS_BYTES, stream);
    if (e != hipSuccess) fprintf(stderr, "cooperative launch failed: %s (grid %d)\n", hipGetErrorString(e), grid);
#else
#ifndef PROBE_DUP2
#define PROBE_DUP2 -1
#endif
#ifndef PROBE_DUP
#define PROBE_DUP -1
#endif
#ifndef PROBE_DRY4
#define PROBE_DRY4 0
#endif
    for (int k = 0; k < 10; ++k) { p.ph_lo = k; p.ph_hi = k;
#ifndef PROBE_DRY1
#define PROBE_DRY1 0
#endif
#ifndef PROBE_DRY2
#define PROBE_DRY2 0
#endif
        if (k == 2 && PROBE_DRY2) { p.dry = 32; hipLaunchKernelGGL(mega, dim3(grid), dim3(512), LDS_BYTES, stream, p); p.dry = 0; }
        if (k == 1 && PROBE_DRY1) { p.dry = 4; hipLaunchKernelGGL(mega, dim3(grid), dim3(512), LDS_BYTES, stream, p); p.dry = 0; }
        if (k == 4 && PROBE_DRY4) { p.dry = PROBE_DRY4; hipLaunchKernelGGL(mega, dim3(grid), dim3(512), LDS_BYTES, stream, p); p.dry = 0; }
        hipLaunchKernelGGL(mega, dim3(grid), dim3(512), LDS_BYTES, stream, p);
        if (k == PROBE_DUP || k == PROBE_DUP2) hipLaunchKernelGGL(mega, dim3(grid), dim3(512), LDS_BYTES, stream, p); }
#endif
}
```

```cpp
#include <hip/hip_runtime.h>
#include <hip/hip_cooperative_groups.h>
#include <cstdio>
namespace cg = cooperative_groups;

#define LAS __attribute__((address_space(3)))
typedef unsigned short bf16_t;
typedef short bf16x8 __attribute__((ext_vector_type(8)));
typedef float f32x4 __attribute__((ext_vector_type(4)));
typedef float f32x2 __attribute__((ext_vector_type(2)));
typedef unsigned u32x4 __attribute__((ext_vector_type(4)));
typedef unsigned u32x2 __attribute__((ext_vector_type(2)));

constexpr int T_TOK = 32768, DM = 1024, SEQ = 2048, NBATCH = 16, NCHUNK = 16, CH = 128;
constexpr int LDA_SEG = 2560;
constexpr int N_INP = 7168;
constexpr size_t MiB = 1ull << 20;
constexpr size_t OFF_SEGA = 0;
constexpr size_t OFF_SEGB = 160 * MiB;
constexpr size_t OFF_STATES = 320 * MiB;
constexpr size_t OFF_XN = 416 * MiB;
constexpr size_t OFF_WIN = 480 * MiB;
constexpr size_t OFF_DTV = 495 * MiB;
constexpr size_t OFF_E = 498 * MiB;
constexpr size_t OFF_TAB = 502 * MiB;
constexpr size_t OFF_WGLU = OFF_TAB;
constexpr size_t OFF_LAM = OFF_TAB + 512 * 1024;
constexpr size_t OFF_LAML = OFF_LAM + 16 * 1024;
constexpr size_t OFF_BBT = OFF_LAML + 16 * 1024;
constexpr size_t OFF_CWT = OFF_BBT + 256 * 1024;
constexpr size_t OFF_CDEC = OFF_CWT + 128 * 1024;
constexpr size_t OFF_BAR = OFF_CDEC + 32 * 1024;
constexpr size_t OFF_WDT = OFF_BAR + 16 * 1024;
constexpr size_t WS_NEED = 504 * MiB;
constexpr size_t OFF_M5 = OFF_SEGB;
constexpr size_t OFF_MERGED = OFF_SEGB + 64 * MiB;
constexpr size_t OFF_PBF = OFF_XN + 8 * MiB;
constexpr size_t OFF_W5T = OFF_XN + 24 * MiB;
constexpr size_t OFF_WSST = OFF_XN + 25 * MiB;
constexpr size_t OFF_WOUTT = OFF_XN + 28 * MiB;
constexpr size_t OFF_WPGT = OFF_XN + 30 * MiB;
constexpr size_t OFF_WPPT = OFF_XN + 32 * MiB;
constexpr size_t OFF_PLEP = OFF_STATES;
constexpr size_t OFF_SS1 = OFF_XN;
constexpr size_t OFF_SS2 = OFF_XN + 2 * MiB;

constexpr int LDS_BYTES = 131072 + 16;

struct Params {
    const float *x, *p, *norm_w, *w_in, *a_re, *a_im, *b_re, *b_im, *c_re, *c_im, *s5d, *logstep, *wglu, *bglu,
        *convw, *convb, *dtbias, *alog, *ssdd, *ssdnw, *wbr5, *wbrs, *wout, *plenw, *wpg, *wpp, *fnw;
    float* out; unsigned char* ws; int ph_lo, ph_hi, dry, pad;
};

typedef __bf16 bf16x2_t __attribute__((ext_vector_type(2)));
__device__ __forceinline__ unsigned pk2(float lo, float hi) { f32x2 v = {lo, hi}; bf16x2_t r = __builtin_convertvector(v, bf16x2_t); unsigned u; __builtin_memcpy(&u, &r, 4); return u; }
__device__ __forceinline__ float bflo(unsigned w) { return __uint_as_float(w << 16); }
__device__ __forceinline__ float bfhi(unsigned w) { return __uint_as_float(w & 0xffff0000u); }
__device__ __forceinline__ float sigmoidf_(float v) { return __builtin_amdgcn_rcpf(1.0f + __expf(-v)); }
__device__ __forceinline__ float siluf_(float v) { return v * __builtin_amdgcn_rcpf(1.0f + __expf(-v)); }
__device__ __forceinline__ float softplusf_(float v) { return fmaxf(v, 0.f) + log1pf(__expf(-fabsf(v))); }
__device__ __forceinline__ float geluf_(float v) { const float u = 0.7978845608028654f * (v + 0.044715f * v * v * v); const float t = 1.0f - 2.0f * __builtin_amdgcn_rcpf(1.0f + __expf(2.0f * u)); return 0.5f * v * (1.0f + t); }
__device__ __forceinline__ float wave_sum(float s) {
#pragma unroll
    for (int o = 32; o > 0; o >>= 1) s += __shfl_xor(s, o);
    return s;
}
__device__ __forceinline__ void unpack8(const u32x4 w, float (&f)[8]) { f[0] = bflo(w.x); f[1] = bfhi(w.x); f[2] = bflo(w.y); f[3] = bfhi(w.y); f[4] = bflo(w.z); f[5] = bfhi(w.z); f[6] = bflo(w.w); f[7] = bfhi(w.w); }
__device__ __forceinline__ u32x4 pack8(const float (&f)[8]) { u32x4 w; w.x = pk2(f[0], f[1]); w.y = pk2(f[2], f[3]); w.z = pk2(f[4], f[5]); w.w = pk2(f[6], f[7]); return w; }

namespace pg8 {
constexpr int BM = 256, BK = 64, HALF = 128, HTB = HALF * BK * 2, STAGE_BYTES = 8 * HTB, NXCD = 8, WGM = 8;
__device__ __forceinline__ int lds_byte(int r, int c) { const int st = (r >> 4) * 2 + (c >> 5), rr = r & 15, cc = c & 31, ob = rr * 64 + cc * 2; return st * 1024 + (ob ^ (((ob >> 9) & 1) << 5)); }
__device__ __forceinline__ void stage_rc(int b, int& R, int& C) { const int st = b / 1024, sb = b % 1024, swz = sb ^ (((sb >> 9) & 1) << 5); R = (st >> 1) * 16 + swz / 64; C = (st & 1) * 32 + (swz % 64) / 2; }
__device__ __forceinline__ int perm32(int rho) { const int n = rho >> 4, i = rho & 15; return 8 * (i >> 2) + 4 * n + (i & 3); }
struct Unit { int pm, pn; };
struct Gemm { const bf16_t* A; const bf16_t* Bt; int lda, ldb, M, N, K; };
struct StaticOrder {
    int nM, nN, nwg, G, c;
    __device__ void init(int M, int N, int G_, int c_) { nM = M / BM; nN = N / BM; nwg = nM * nN; G = G_; c = c_; }
    __device__ bool next(int i, Unit& u) const {
        const long L = (long)i * G + c; if (L >= nwg) return false;
        int wgid = (int)L; { const int q = nwg / NXCD, r = nwg % NXCD, xcd = wgid % NXCD, off = wgid / NXCD; wgid = (xcd < r ? xcd * (q + 1) : r * (q + 1) + (xcd - r) * q) + off; }
        const int nig = WGM * nN, gid = wgid / nig, fm = gid * WGM, gsz = (nM - fm) < WGM ? (nM - fm) : WGM;
        u.pm = fm + ((wgid % nig) % gsz); u.pn = (wgid % nig) / gsz; return true;
    }
};
template <class Epi>
__device__ __forceinline__ void gemm_phase(LAS unsigned char* lds, const Gemm g, const StaticOrder& S, const Epi& E) {
    const int tid = threadIdx.x, wid = __builtin_amdgcn_readfirstlane(tid >> 6), lane = tid & 63, wr = wid >> 2, wc = wid & 3, fr = lane & 15, fq = lane >> 4;
    const int K = g.K, nt = K / BK;
    unsigned voffA[2], voffB[2];
#pragma unroll
    for (int i = 0; i < 2; ++i) { int R, C; stage_rc(tid * 16 + i * 8192, R, C); const int Rb = (R & ~31) + perm32(R & 31);
        voffA[i] = (unsigned)(R * g.lda + C) * 2u; voffB[i] = (unsigned)(Rb * g.ldb + C) * 2u; }
    const size_t kstep = (size_t)(BK * 2);
    const size_t hstepA = (size_t)HALF * g.lda * 2, hstepB = (size_t)HALF * g.ldb * 2;
    const size_t tstepA = 2 * hstepA, tstepB = 2 * hstepB;
    const unsigned ldsw = (unsigned)wid * 1024u;
    const int aoff = lds_byte(wr * 64 + fr, fq * 8), boff = lds_byte(wc * 32 + fr, fq * 8);
#define PG8_SA(b, h) (((b) * 2 + (h)) * HTB)
#define PG8_SB(b, h) ((4 + (b) * 2 + (h)) * HTB)
#define PG8_STAGE(bufoff, gbase, voff) do { _Pragma("unroll") for (int _i = 0; _i < 2; ++_i) \
        __builtin_amdgcn_global_load_lds((const unsigned*)((const char*)(gbase) + (voff)[_i]), (LAS unsigned*)(lds + (bufoff) + ldsw + _i * 8192), 16, 0, 0); } while (0)
#define PG8_LDA(dst, b, h) do { _Pragma("unroll") for (int m = 0; m < 4; ++m) _Pragma("unroll") for (int k = 0; k < 2; ++k) dst[m][k] = *(const LAS bf16x8*)(lds + PG8_SA(b, h) + aoff + m * 2048 + k * 1024); } while (0)
#define PG8_LDB(dst, b, h) do { _Pragma("unroll") for (int n = 0; n < 2; ++n) _Pragma("unroll") for (int k = 0; k < 2; ++k) dst[n][k] = *(const LAS bf16x8*)(lds + PG8_SB(b, h) + boff + n * 2048 + k * 1024); } while (0)
#define PG8_MMA(ai, bj, At, Bt) do { __builtin_amdgcn_s_setprio(1); _Pragma("unroll") for (int m = 0; m < 4; ++m) _Pragma("unroll") for (int n = 0; n < 2; ++n) _Pragma("unroll") for (int k = 0; k < 2; ++k) \
        acc[ai][bj][m][n] = __builtin_amdgcn_mfma_f32_16x16x32_bf16(Bt[n][k], At[m][k], acc[ai][bj][m][n], 0, 0, 0); __builtin_amdgcn_s_setprio(0); } while (0)
#define PG8_WAIT_V(n) asm volatile("s_waitcnt vmcnt(" #n ")" ::: "memory")
#define PG8_WAIT_L(n) asm volatile("s_waitcnt lgkmcnt(" #n ")" ::: "memory")
#define PG8_BAR __builtin_amdgcn_s_barrier()
#define PG8_SCHED __builtin_amdgcn_sched_barrier(0)
    Unit cur, nxt; int ui = 0;
    if (!S.next(0, cur)) return;
    f32x4 acc[2][2][4][2];
#pragma unroll
    for (int a = 0; a < 2; ++a)
#pragma unroll
        for (int b = 0; b < 2; ++b)
#pragma unroll
            for (int m = 0; m < 4; ++m)
#pragma unroll
                for (int n = 0; n < 2; ++n) acc[a][b][m][n] = (f32x4){0.f, 0.f, 0.f, 0.f};
    bf16x8 At[4][2], B0[2][2], B1[2][2];
    const char* cA = (const char*)g.A + (size_t)cur.pm * tstepA; const char* cB = (const char*)g.Bt + (size_t)cur.pn * tstepB;
    PG8_STAGE(PG8_SB(0, 0), cB, voffB); PG8_STAGE(PG8_SA(0, 0), cA, voffA); PG8_STAGE(PG8_SB(0, 1), cB + hstepB, voffB); PG8_STAGE(PG8_SA(0, 1), cA + hstepA, voffA);
    if (wr == 1) PG8_BAR;
    PG8_WAIT_V(4); PG8_BAR;
    PG8_STAGE(PG8_SB(1, 0), cB + kstep, voffB); PG8_STAGE(PG8_SA(1, 0), cA + kstep, voffA); PG8_STAGE(PG8_SB(1, 1), cB + hstepB + kstep, voffB);
    PG8_WAIT_V(6); PG8_BAR;
    for (;;) {
        const bool has_next = S.next(ui + 1, nxt);
        const char* nA = has_next ? (const char*)g.A + (size_t)nxt.pm * tstepA : cA; const char* nB = has_next ? (const char*)g.Bt + (size_t)nxt.pn * tstepB : cB;
        for (int t = 0; t < nt; t += 2) {
            const bool last = (t == nt - 2);
            const char* a1 = cA + (size_t)(t + 1) * kstep;
            const char* a2 = last ? nA : cA + (size_t)(t + 2) * kstep; const char* b2 = last ? nB : cB + (size_t)(t + 2) * kstep;
            const char* a3 = a2 + kstep; const char* b3 = b2 + kstep;
            PG8_LDB(B0, 0, 0); PG8_SCHED; PG8_LDA(At, 0, 0); PG8_STAGE(PG8_SA(1, 1), a1 + hstepA, voffA);
            PG8_WAIT_L(8); PG8_BAR; PG8_WAIT_L(0); PG8_MMA(0, 0, At, B0); PG8_BAR; PG8_SCHED;
            PG8_LDB(B1, 0, 1); PG8_STAGE(PG8_SB(0, 0), b2, voffB);
            PG8_BAR; PG8_WAIT_L(0); PG8_MMA(0, 1, At, B1); PG8_BAR;
            PG8_LDA(At, 0, 1); PG8_STAGE(PG8_SA(0, 0), a2, voffA);
            PG8_BAR; PG8_WAIT_L(0); PG8_MMA(1, 0, At, B0); PG8_BAR; PG8_SCHED;
            PG8_STAGE(PG8_SB(0, 1), b2 + hstepB, voffB);
            PG8_WAIT_V(6); PG8_BAR; PG8_MMA(1, 1, At, B1); PG8_BAR;
            PG8_LDB(B0, 1, 0); PG8_SCHED; PG8_LDA(At, 1, 0); PG8_STAGE(PG8_SA(0, 1), a2 + hstepA, voffA);
            PG8_WAIT_L(8); PG8_BAR; PG8_WAIT_L(0); PG8_MMA(0, 0, At, B0); PG8_BAR; PG8_SCHED;
            PG8_LDB(B1, 1, 1); PG8_STAGE(PG8_SB(1, 0), b3, voffB);
            PG8_BAR; PG8_WAIT_L(0); PG8_MMA(0, 1, At, B1); PG8_BAR;
            PG8_LDA(At, 1, 1); PG8_STAGE(PG8_SA(1, 0), a3, voffA);
            PG8_BAR; PG8_WAIT_L(0); PG8_MMA(1, 0, At, B0); PG8_BAR; PG8_SCHED;
            PG8_STAGE(PG8_SB(1, 1), b3 + hstepB, voffB);
            PG8_WAIT_V(6); PG8_BAR; PG8_MMA(1, 1, At, B1); PG8_BAR;
        }
        E(acc, cur, wr, wc, fr, fq);
        if (!has_next) break;
#pragma unroll
        for (int a = 0; a < 2; ++a)
#pragma unroll
            for (int b = 0; b < 2; ++b)
#pragma unroll
                for (int m = 0; m < 4; ++m)
#pragma unroll
                    for (int n = 0; n < 2; ++n) acc[a][b][m][n] = (f32x4){0.f, 0.f, 0.f, 0.f};
        cur = nxt; cA = nA; cB = nB; ++ui;
    }
    PG8_WAIT_V(0);
    if (wr == 0) PG8_BAR;
    PG8_BAR;
#undef PG8_SA
#undef PG8_SB
#undef PG8_STAGE
#undef PG8_LDA
#undef PG8_LDB
#undef PG8_MMA
#undef PG8_WAIT_V
#undef PG8_WAIT_L
#undef PG8_BAR
#undef PG8_SCHED
}
}
typedef f32x4 AccT[2][2][4][2];

struct EpiInProj {
    bf16_t *segA, *segB, *gates; float* dtv; const float* dtbias; int dry;
    __device__ __forceinline__ void operator()(const AccT& acc, const pg8::Unit& u, int wr, int wc, int fr, int fq) const {
        if (dry & 4) return;
        const int pn = u.pn, row0 = u.pm * 256 + wr * 64 + fr;
        {
            bf16_t* base; int ld, colt, act;
            if (pn < 10) { base = segA; ld = LDA_SEG; colt = pn * 256; act = 0; }
            else if (pn < 20) { base = segB; ld = LDA_SEG; colt = (pn - 10) * 256; act = 0; }
            else { base = gates; ld = 2048; colt = (pn - 20) * 256; act = 2; }
            const int col0 = colt + wc * 32 + 8 * fq;
#pragma unroll
            for (int ai = 0; ai < 2; ++ai)
#pragma unroll
                for (int m = 0; m < 4; ++m) { bf16_t* rowp = base + (size_t)(row0 + ai * 128 + m * 16) * ld + col0;
#pragma unroll
                    for (int bj = 0; bj < 2; ++bj) { f32x4 v0 = acc[ai][bj][m][0], v1 = acc[ai][bj][m][1];
                        if (act == 1) {
#pragma unroll
                            for (int j = 0; j < 4; ++j) { v0[j] = siluf_(v0[j]); v1[j] = siluf_(v1[j]); } }
                        if (act == 2) {
#pragma unroll
                            for (int j = 0; j < 4; ++j) { v0[j] = sigmoidf_(v0[j]); v1[j] = sigmoidf_(v1[j]); } }
                        u32x4 w; w.x = pk2(v0[0], v0[1]); w.y = pk2(v0[2], v0[3]); w.z = pk2(v1[0], v1[1]); w.w = pk2(v1[2], v1[3]);
                        *(u32x4*)(rowp + bj * 128) = w; } }
        }
    }
};
struct EpiGlu {
    bf16_t* segA; const float* bglu;
    __device__ __forceinline__ void operator()(const AccT& acc, const pg8::Unit& u, int wr, int wc, int fr, int fq) const {
        const int row0 = u.pm * 256 + wr * 64 + fr, col0 = u.pn * 256 + wc * 32 + 8 * fq;
        f32x4 bb[2][2];
#pragma unroll
        for (int bj = 0; bj < 2; ++bj) { bb[bj][0] = *(const f32x4*)(bglu + col0 + bj * 128); bb[bj][1] = *(const f32x4*)(bglu + col0 + bj * 128 + 4); }
#pragma unroll
        for (int ai = 0; ai < 2; ++ai) {
            u32x4 yw[4][2], zw[4][2];
#pragma unroll
            for (int m = 0; m < 4; ++m)
#pragma unroll
                for (int bj = 0; bj < 2; ++bj) { const bf16_t* rowp = segA + (size_t)(row0 + ai * 128 + m * 16) * LDA_SEG + col0 + bj * 128; yw[m][bj] = *(const u32x4*)rowp; zw[m][bj] = *(const u32x4*)(rowp + 512); }
#pragma unroll
            for (int m = 0; m < 4; ++m)
#pragma unroll
                for (int bj = 0; bj < 2; ++bj) { bf16_t* rowp = segA + (size_t)(row0 + ai * 128 + m * 16) * LDA_SEG + col0 + bj * 128;
                    float y[8], z[8], o[8]; unpack8(yw[m][bj], y); unpack8(zw[m][bj], z);
#pragma unroll
                    for (int j = 0; j < 4; ++j) { o[j] = y[j] * sigmoidf_(acc[ai][bj][m][0][j] + bb[bj][0][j]) * siluf_(z[j]); o[4 + j] = y[4 + j] * sigmoidf_(acc[ai][bj][m][1][j] + bb[bj][1][j]) * siluf_(z[4 + j]); }
                    *(u32x4*)(rowp + 512) = pack8(o); }
            asm volatile("" ::: "memory"); }
    }
};
template <int MODE> struct EpiMerge {
    bf16_t* dst; const bf16_t* gates; const bf16_t* m5;
    __device__ __forceinline__ void operator()(const AccT& acc, const pg8::Unit& u, int wr, int wc, int fr, int fq) const {
        const int row0 = u.pm * 256 + wr * 64 + fr, col0 = u.pn * 256 + wc * 32 + 8 * fq;
#pragma unroll
        for (int ai = 0; ai < 2; ++ai) {
            u32x4 gw[4][2], mw[4][2];
            if (MODE != 2) {
#pragma unroll
                for (int m = 0; m < 4; ++m)
#pragma unroll
                    for (int bj = 0; bj < 2; ++bj) { const size_t r = (size_t)(row0 + ai * 128 + m * 16); const int c = col0 + bj * 128;
                        gw[m][bj] = *(const u32x4*)(gates + r * 2048 + (MODE == 1 ? 1024 : 0) + c); if (MODE == 1) mw[m][bj] = *(const u32x4*)(m5 + r * 1024 + c); } }
#pragma unroll
            for (int m = 0; m < 4; ++m)
#pragma unroll
                for (int bj = 0; bj < 2; ++bj) { const size_t r = (size_t)(row0 + ai * 128 + m * 16); const int c = col0 + bj * 128;
                    float o[8];
#pragma unroll
                    for (int j = 0; j < 4; ++j) { o[j] = acc[ai][bj][m][0][j]; o[4 + j] = acc[ai][bj][m][1][j]; }
                    if (MODE == 0) { float gt[8]; unpack8(gw[m][bj], gt);
#pragma unroll
                        for (int j = 0; j < 8; ++j) o[j] *= gt[j]; }
                    if (MODE == 1) { float gt[8], mm[8]; unpack8(gw[m][bj], gt); unpack8(mw[m][bj], mm);
#pragma unroll
                        for (int j = 0; j < 8; ++j) o[j] = mm[j] + gt[j] * o[j]; }
                    *(u32x4*)(dst + r * 1024 + c) = pack8(o); }
            asm volatile("" ::: "memory"); }
    }
};
struct EpiOut {
    const float* x; bf16_t* hbf; float* ss;
    __device__ __forceinline__ void operator()(const AccT& acc, const pg8::Unit& u, int wr, int wc, int fr, int fq) const {
        const int row0 = u.pm * 256 + wr * 64 + fr, col0 = u.pn * 256 + wc * 32 + 8 * fq;
#pragma unroll
        for (int ai = 0; ai < 2; ++ai) {
            f32x4 xv[4][2][2];
#pragma unroll
            for (int m = 0; m < 4; ++m)
#pragma unroll
                for (int bj = 0; bj < 2; ++bj) { const float* xp = x + (size_t)(row0 + ai * 128 + m * 16) * 1024 + col0 + bj * 128; xv[m][bj][0] = *(const f32x4*)xp; xv[m][bj][1] = *(const f32x4*)(xp + 4); }
#pragma unroll
            for (int m = 0; m < 4; ++m) { const size_t r = (size_t)(row0 + ai * 128 + m * 16); float s = 0.f;
#pragma unroll
                for (int bj = 0; bj < 2; ++bj) { const int c = col0 + bj * 128;
                    const f32x4 h0 = xv[m][bj][0] + acc[ai][bj][m][0], h1 = xv[m][bj][1] + acc[ai][bj][m][1];
                    u32x4 w; w.x = pk2(h0[0], h0[1]); w.y = pk2(h0[2], h0[3]); w.z = pk2(h1[0], h1[1]); w.w = pk2(h1[2], h1[3]);
                    *(u32x4*)(hbf + r * 1024 + c) = w;
#pragma unroll
                    for (int j = 0; j < 4; ++j) s += h0[j] * h0[j] + h1[j] * h1[j]; }
                s += __shfl_xor(s, 16); s += __shfl_xor(s, 32);
                if (fq == 0) ss[r * 16 + u.pn * 4 + wc] = s; }
            asm volatile("" ::: "memory"); }
    }
};
struct EpiPle {
    const bf16_t* h1bf; bf16_t* h2bf; const bf16_t* plep; const float* ss1; float* ss2;
    __device__ __forceinline__ void operator()(const AccT& acc, const pg8::Unit& u, int wr, int wc, int fr, int fq) const {
        const int row0 = u.pm * 256 + wr * 64 + fr, col0 = u.pn * 256 + wc * 32 + 8 * fq;
#pragma unroll
        for (int ai = 0; ai < 2; ++ai)
#pragma unroll
            for (int mp = 0; mp < 2; ++mp) {
                f32x4 q[2][4]; u32x4 pw[2][2], hw[2][2];
#pragma unroll
                for (int mm = 0; mm < 2; ++mm) { const size_t r = (size_t)(row0 + ai * 128 + (2 * mp + mm) * 16);
#pragma unroll
                    for (int k = 0; k < 4; ++k) q[mm][k] = *(const f32x4*)(ss1 + r * 16 + 4 * k);
#pragma unroll
                    for (int bj = 0; bj < 2; ++bj) { const size_t o = r * 1024 + col0 + bj * 128; pw[mm][bj] = *(const u32x4*)(plep + o); hw[mm][bj] = *(const u32x4*)(h1bf + o); } }
#pragma unroll
                for (int mm = 0; mm < 2; ++mm) { const int m = 2 * mp + mm; const size_t r = (size_t)(row0 + ai * 128 + m * 16); float s = 0.f;
                    const f32x4 qs = (q[mm][0] + q[mm][1]) + (q[mm][2] + q[mm][3]);
                    const float rstd = rsqrtf(((qs[0] + qs[1]) + (qs[2] + qs[3])) * (1.0f / 1024.0f) + 1e-6f);
#pragma unroll
                    for (int bj = 0; bj < 2; ++bj) { const int c = col0 + bj * 128;
                        float pp[8], hh[8]; unpack8(pw[mm][bj], pp); unpack8(hw[mm][bj], hh);
#pragma unroll
                        for (int j = 0; j < 4; ++j) { hh[j] += sigmoidf_(rstd * acc[ai][bj][m][0][j]) * pp[j]; hh[4 + j] += sigmoidf_(rstd * acc[ai][bj][m][1][j]) * pp[4 + j]; }
                        *(u32x4*)(h2bf + r * 1024 + c) = pack8(hh);
#pragma unroll
                        for (int j = 0; j < 8; ++j) s += hh[j] * hh[j]; }
                    s += __shfl_xor(s, 16); s += __shfl_xor(s, 32);
                    if (fq == 0) ss2[r * 16 + u.pn * 4 + wc] = s; }
                asm volatile("" ::: "memory"); }
    }
};

template <int MODE>
__device__ __forceinline__ void xpose_tiles(const float* __restrict__ src, int ldn, int K, bf16_t* __restrict__ dst, int Ndst, const float* __restrict__ kscale, LAS float* tile, int wg, int nwg) {
    const int nkt = K / 64, ntile = nkt * (Ndst / 64);
    for (int t = wg; t < ntile; t += nwg) {
        const int n0 = (t / nkt) * 64, k0 = (t % nkt) * 64;
        { const int r = threadIdx.x >> 4, c4 = (threadIdx.x & 15) * 4;
#pragma unroll
          for (int i = 0; i < 2; ++i) { const int k = k0 + r + 32 * i, n = n0 + c4; int sc = n;
              if (MODE == 1) sc = n < 5120 ? n : n + 24;
              if (MODE == 2) sc = n < 24 ? 5120 + n : -1;
              f32x4 v = (f32x4){0.f, 0.f, 0.f, 0.f};
              if (sc >= 0) v = *(const f32x4*)(src + (size_t)k * ldn + sc);
              if (kscale) v *= kscale[k];
              LAS float* tp = tile + (r + 32 * i) * 65 + c4; tp[0] = v[0]; tp[1] = v[1]; tp[2] = v[2]; tp[3] = v[3]; } }
        __syncthreads();
        { const int n = threadIdx.x >> 3, k8 = (threadIdx.x & 7) * 8; float f[8];
#pragma unroll
          for (int j = 0; j < 8; ++j) f[j] = tile[(k8 + j) * 65 + n];
          *(u32x4*)(dst + (size_t)(n0 + n) * K + k0 + k8) = pack8(f); }
        __syncthreads();
    }
}

__device__ __forceinline__ void dsincos(double x, double& s, double& c) {
    const double twopi = 6.283185307179586476925, hp = 1.5707963267948966192;
    x -= rint(x / twopi) * twopi;
    const double q = rint(x / hp); const double r = x - q * hp; const int qi = ((int)q) & 3;
    const double r2 = r * r;
    double sn = r * (1.0 + r2 * (-1.0 / 6 + r2 * (1.0 / 120 + r2 * (-1.0 / 5040 + r2 * (1.0 / 362880 + r2 * (-1.0 / 39916800 + r2 * (1.0 / 6227020800.0)))))));
    double cs = 1.0 + r2 * (-0.5 + r2 * (1.0 / 24 + r2 * (-1.0 / 720 + r2 * (1.0 / 40320 + r2 * (-1.0 / 3628800 + r2 * (1.0 / 479001600.0 + r2 * (-1.0 / 87178291200.0)))))));
    if (qi == 0) { s = sn; c = cs; } else if (qi == 1) { s = cs; c = -sn; } else if (qi == 2) { s = -sn; c = -cs; } else { s = -cs; c = sn; }
}
__device__ __forceinline__ void phase0(const Params& p, LAS unsigned char* lds) {
    const int tid = threadIdx.x, lane = tid & 63, gw = blockIdx.x * 8 + (tid >> 6), nw = gridDim.x * 8;
    bf16_t* xn = (bf16_t*)(p.ws + OFF_XN);
    for (int row0 = gw * 4; row0 < T_TOK; row0 += nw * 4) {
        f32x4 v[4][4]; float ss[4];
#pragma unroll
        for (int rr = 0; rr < 4; ++rr) { const f32x4* xr = (const f32x4*)(p.x + (size_t)(row0 + rr) * DM);
#pragma unroll
            for (int i = 0; i < 4; ++i) v[rr][i] = xr[lane + 64 * i]; }
#pragma unroll
        for (int rr = 0; rr < 4; ++rr) { float a = 0.f;
#pragma unroll
            for (int i = 0; i < 4; ++i) a += (v[rr][i][0] * v[rr][i][0] + v[rr][i][1] * v[rr][i][1]) + (v[rr][i][2] * v[rr][i][2] + v[rr][i][3] * v[rr][i][3]);
            ss[rr] = rsqrtf(wave_sum(a) * (1.0f / 1024.0f) + 1e-6f); }
#pragma unroll
        for (int i = 0; i < 4; ++i) { const f32x4 w = ((const f32x4*)p.norm_w)[lane + 64 * i];
#pragma unroll
            for (int rr = 0; rr < 4; ++rr) { const float r = ss[rr]; u32x2 o; o.x = pk2(v[rr][i][0] * r * w[0], v[rr][i][1] * r * w[1]); o.y = pk2(v[rr][i][2] * r * w[2], v[rr][i][3] * r * w[3]);
                *(u32x2*)(xn + (size_t)(row0 + rr) * DM + 4 * (lane + 64 * i)) = o; } }
    }
    xpose_tiles<1>(p.w_in, 7192, 1024, (bf16_t*)(p.ws + OFF_WIN), N_INP, nullptr, (LAS float*)lds, blockIdx.x, gridDim.x);
    xpose_tiles<2>(p.w_in, 7192, 1024, (bf16_t*)(p.ws + OFF_WDT), 64, nullptr, (LAS float*)lds, blockIdx.x, gridDim.x);
    xpose_tiles<0>(p.wglu, 512, 512, (bf16_t*)(p.ws + OFF_WGLU), 512, nullptr, (LAS float*)lds, blockIdx.x, gridDim.x);
    for (int gt = gw; gt < 2048; gt += nw) {
        const int g = gt >> 6, pp = gt & 63;
        const double step = exp((double)p.logstep[g]), ar = p.a_re[gt], ai = p.a_im[gt];
        const double mag = exp(ar * step); double sn, cs; dsincos(ai * step, sn, cs);
        const double lr = mag * cs, li = mag * sn, den = ar * ar + ai * ai, nr = lr - 1.0, ni = li;
        const double fre = (nr * ar + ni * ai) / den, fim = (ni * ar - nr * ai) / den;
        double pr = lr, pi = li;
#pragma unroll
        for (int i = 0; i < 7; ++i) { const double t = pr * pr - pi * pi; pi = 2.0 * pr * pi; pr = t; }
        if (lane == 0) { float* lam = (float*)(p.ws + OFF_LAM); float* lamL = (float*)(p.ws + OFF_LAML);
            lam[gt * 2] = (float)lr; lam[gt * 2 + 1] = (float)li; lamL[gt * 2] = (float)pr; lamL[gt * 2 + 1] = (float)pi; }
        bf16_t* bbt = (bf16_t*)(p.ws + OFF_BBT) + (size_t)g * 128 * 32; bf16_t* cwt = (bf16_t*)(p.ws + OFF_CWT) + (size_t)g * 16 * 128;
        if (lane < 16) { const int h = lane;
            const double br = p.b_re[gt * 16 + h], bi = p.b_im[gt * 16 + h];
            bbt[pp * 32 + h] = (bf16_t)(pk2((float)(fre * br - fim * bi), 0.f) & 0xffffu);
            bbt[(64 + pp) * 32 + h] = (bf16_t)(pk2((float)(fre * bi + fim * br), 0.f) & 0xffffu);
            cwt[h * 128 + pp] = (bf16_t)(pk2(p.c_re[(g * 16 + h) * 64 + pp], 0.f) & 0xffffu);
            cwt[h * 128 + 64 + pp] = (bf16_t)(pk2(-p.c_im[(g * 16 + h) * 64 + pp], 0.f) & 0xffffu);
        } else if (lane < 32) { bbt[pp * 32 + lane] = 0; bbt[(64 + pp) * 32 + lane] = 0; }
    }
}

template <int NCH> struct ConvMap { static constexpr int NOCT = NCH / 8, RUNS = 512 / NOCT, RL = 128 / RUNS; };
__device__ __forceinline__ void conv_load(const Params& p, int b, int c, int ch0, u32x4 (&raw)[7]) {
    const int co = threadIdx.x & 15, t0 = (threadIdx.x >> 4) * 4, ch = ch0 + co * 8;
    const bf16_t* segB = (const bf16_t*)(p.ws + OFF_SEGB);
#pragma unroll
    for (int i = 0; i < 7; ++i) { const int l = c * CH + t0 - 3 + i;
        raw[i] = (u32x4){0u, 0u, 0u, 0u};
        if (l >= 0) raw[i] = *(const u32x4*)(segB + (size_t)(b * SEQ + l) * LDA_SEG + ch); }
}
constexpr int CW_OFF = 112640;
__device__ __forceinline__ void conv_fill(const Params& p, LAS unsigned char* lds, int g) {
    LAS float* cw = (LAS float*)(lds + CW_OFF);
    for (int idx = threadIdx.x; idx < 5 * 5 * 128; idx += 512) { const int tile = idx / 640, k = (idx % 640) >> 7, ch = idx & 127;
        const int cb = tile < 3 ? (g * 6 + 2 * tile) * 64 : (tile == 3 ? 1536 + g * 128 : 2048 + g * 128);
        cw[idx] = k < 4 ? p.convw[k * 2560 + cb + ch] : p.convb[cb + ch]; }
    __syncthreads();
}
__device__ __forceinline__ void conv_compute(const LAS float* cwt  , const u32x4 (&raw)[7], float (&o)[4][8], int& t0, int& co) {
    co = threadIdx.x & 15; t0 = (threadIdx.x >> 4) * 4;
    float xr[7][8];
#pragma unroll
    for (int i = 0; i < 7; ++i) unpack8(raw[i], xr[i]);
    float cb[8];
    { const f32x4 b0 = *(const LAS f32x4*)(cwt + 4 * 128 + co * 8), b1 = *(const LAS f32x4*)(cwt + 4 * 128 + co * 8 + 4);
#pragma unroll
      for (int j = 0; j < 4; ++j) { cb[j] = b0[j]; cb[4 + j] = b1[j]; } }
#pragma unroll
    for (int i = 0; i < 4; ++i)
#pragma unroll
        for (int e = 0; e < 8; ++e) o[i][e] = cb[e];
#pragma unroll
    for (int k = 0; k < 4; ++k) { const f32x4 w0 = *(const LAS f32x4*)(cwt + k * 128 + co * 8), w1 = *(const LAS f32x4*)(cwt + k * 128 + co * 8 + 4);
#pragma unroll
        for (int i = 0; i < 4; ++i) {
#pragma unroll
            for (int j = 0; j < 4; ++j) { o[i][j] += w0[j] * xr[i + k][j]; o[i][4 + j] += w1[j] * xr[i + k][4 + j]; } } }
#pragma unroll
    for (int i = 0; i < 4; ++i)
#pragma unroll
        for (int e = 0; e < 8; ++e) o[i][e] = siluf_(o[i][e]);
}

constexpr int LP = 136;
__device__ __forceinline__ int tsw_w(int row, int t0) { return row * LP + ((((t0 >> 3) ^ (row >> 3)) & 15) << 3) + (t0 & 7); }
__device__ __forceinline__ int tsw_r(int row, int kb) { return row * LP + (((kb ^ (row >> 3)) & 15) << 3); }
__device__ __forceinline__ void ssd_acum(const Params& p, int b, int c, int g, LAS float* acum, LAS float* dts) {
    const int wid = threadIdx.x >> 6, lane = threadIdx.x & 63;
    if (wid < 6) {
        const int h = g * 6 + wid; const float A = -__expf(p.alog[h]);
        const float* dtv = (const float*)(p.ws + OFF_DTV) + (size_t)(b * SEQ + c * CH) * 24 + h;
        const float v0 = dtv[(2 * lane) * 24], v1 = dtv[(2 * lane + 1) * 24];
        const float d0 = v0 * A, d1 = v1 * A; float s = d0 + d1, inc = s;
#pragma unroll
        for (int o = 1; o < 64; o <<= 1) { const float t = __shfl_up(inc, o); if (lane >= o) inc += t; }
        const float ex = inc - s;
        acum[wid * 128 + 2 * lane] = ex + d0; acum[wid * 128 + 2 * lane + 1] = ex + d0 + d1;
        dts[wid * 128 + 2 * lane] = v0; dts[wid * 128 + 2 * lane + 1] = v1;
    }
}

__device__ __forceinline__ void ssd_states_item(const Params& p, LAS unsigned char* lds, int item) {
    const int g = item & 3, c = (item >> 2) & 15, b = item >> 6;
    const int tid = threadIdx.x, wid = tid >> 6, lane = tid & 63, fr = lane & 15, fq = lane >> 4;
    LAS bf16_t* BsT = (LAS bf16_t*)lds;
    LAS bf16_t* XdT = (LAS bf16_t*)(lds + 34816);
    LAS float* acum = (LAS float*)(lds + 69632);
    LAS float* dts = (LAS float*)(lds + 72704);
    u32x4 rawA[7], rawB[7];
    conv_load(p, b, c, 1536 + g * 128, rawA);
    conv_load(p, b, c, (g * 6) * 64, rawB);
    ssd_acum(p, b, c, g, acum, dts);
    { float o[4][8]; int t0, co; conv_compute((const LAS float*)(lds + CW_OFF) + 3 * 640, rawA, o, t0, co);
#pragma unroll
      for (int e = 0; e < 8; ++e) { u32x2 w; w.x = pk2(o[0][e], o[1][e]); w.y = pk2(o[2][e], o[3][e]); *(LAS u32x2*)(BsT + tsw_w(co * 8 + e, t0)) = w; } }
    __syncthreads();
    bf16_t* states = (bf16_t*)(p.ws + OFF_STATES);
#pragma unroll 1
    for (int hp = 0; hp < 3; ++hp) {
        { float o[4][8]; int t0, co; conv_compute((const LAS float*)(lds + CW_OFF) + hp * 640, rawB, o, t0, co);
          if (hp < 2) conv_load(p, b, c, (g * 6 + 2 * hp + 2) * 64, rawB);
          const int hl = 2 * hp + (co >> 3); const float alast = acum[hl * 128 + 127]; float sc[4];
#pragma unroll
          for (int i = 0; i < 4; ++i) sc[i] = dts[hl * 128 + t0 + i] * __expf(alast - acum[hl * 128 + t0 + i]);
#pragma unroll
          for (int e = 0; e < 8; ++e) { u32x2 w; w.x = pk2(o[0][e] * sc[0], o[1][e] * sc[1]); w.y = pk2(o[2][e] * sc[2], o[3][e] * sc[3]); *(LAS u32x2*)(XdT + tsw_w(co * 8 + e, t0)) = w; } }
        __syncthreads();
        f32x4 acc[8];
#pragma unroll
        for (int n = 0; n < 8; ++n) acc[n] = (f32x4){0.f, 0.f, 0.f, 0.f};
#pragma unroll
        for (int kk = 0; kk < 4; ++kk) { const bf16x8 xf = *(const LAS bf16x8*)(XdT + tsw_r(wid * 16 + fr, kk * 4 + fq));
#pragma unroll
            for (int n = 0; n < 8; ++n) { const bf16x8 bf = *(const LAS bf16x8*)(BsT + tsw_r(n * 16 + fr, kk * 4 + fq)); acc[n] = __builtin_amdgcn_mfma_f32_16x16x32_bf16(bf, xf, acc[n], 0, 0, 0); } }
        const int h = g * 6 + 2 * hp + (wid >> 2), prow = (wid & 3) * 16 + fr;
        bf16_t* dst = states + ((size_t)((b * NCHUNK + c) * 24 + h) * 64 + prow) * 128 + 4 * fq;
#pragma unroll
        for (int n = 0; n < 8; ++n) { u32x2 w; w.x = pk2(acc[n][0], acc[n][1]); w.y = pk2(acc[n][2], acc[n][3]); *(u32x2*)(dst + n * 16) = w; }
        __syncthreads();
    }
    if (tid < 6) ((float*)(p.ws + OFF_CDEC))[(b * NCHUNK + c) * 24 + g * 6 + tid] = __expf(acum[tid * 128 + 127]);
    __syncthreads();
}

__device__ __forceinline__ void ssd_prefix(const Params& p) {
    bf16_t* states = (bf16_t*)(p.ws + OFF_STATES); const float* cdec = (const float*)(p.ws + OFF_CDEC);
    const int nthr = gridDim.x * 512;
    for (int v = blockIdx.x * 512 + threadIdx.x; v < NBATCH * 24 * 1024; v += nthr) {
        const int bh = v >> 10, e = v & 1023, b = bh / 24, h = bh % 24;
        u32x4 s[NCHUNK];
#pragma unroll
        for (int c = 0; c < NCHUNK; ++c) s[c] = *(const u32x4*)(states + (size_t)((b * NCHUNK + c) * 24 + h) * 8192 + e * 8);
        float prev[8];
#pragma unroll
        for (int j = 0; j < 8; ++j) prev[j] = 0.f;
#pragma unroll
        for (int c = 0; c < NCHUNK; ++c) {
            *(u32x4*)(states + (size_t)((b * NCHUNK + c) * 24 + h) * 8192 + e * 8) = pack8(prev);
            const float d = cdec[(b * NCHUNK + c) * 24 + h]; float f[8]; unpack8(s[c], f);
#pragma unroll
            for (int j = 0; j < 8; ++j) prev[j] = prev[j] * d + f[j];
        }
    }
}

__device__ __forceinline__ void ssd_out_item(const Params& p, LAS unsigned char* lds, int item) {
    const int g = item & 3, c = (item >> 2) & 15, b = item >> 6;
    const int tid = threadIdx.x, wid = tid >> 6, lane = tid & 63, fr = lane & 15, fq = lane >> 4;
    LAS bf16_t* Cs = (LAS bf16_t*)lds;
    LAS bf16_t* Bs = (LAS bf16_t*)(lds + 34816);
    LAS bf16_t* XT = (LAS bf16_t*)(lds + 69632);
    LAS float* acum = (LAS float*)(lds + 104448);
    LAS float* dts = (LAS float*)(lds + 107520);
    LAS float* red = (LAS float*)(lds + 110592);
    const size_t tok0 = (size_t)b * SEQ + c * CH;
    u32x4 rawA[7], rawB[7];
    conv_load(p, b, c, 2048 + g * 128, rawA);
    conv_load(p, b, c, 1536 + g * 128, rawB);
    ssd_acum(p, b, c, g, acum, dts);
    { float o[4][8]; int t0, co; conv_compute((const LAS float*)(lds + CW_OFF) + 4 * 640, rawA, o, t0, co);
#pragma unroll
      for (int i = 0; i < 4; ++i) *(LAS u32x4*)(Cs + (t0 + i) * LP + co * 8) = pack8(o[i]); }
    conv_load(p, b, c, (g * 6) * 64, rawA);
    { float o[4][8]; int t0, co; conv_compute((const LAS float*)(lds + CW_OFF) + 3 * 640, rawB, o, t0, co);
#pragma unroll
      for (int i = 0; i < 4; ++i) *(LAS u32x4*)(Bs + (t0 + i) * LP + co * 8) = pack8(o[i]); }
    __syncthreads();
    LAS float* vtab = (LAS float*)(lds + 125440);
    for (int idx = tid; idx < 6 * 128; idx += 512) vtab[idx] = __expf(acum[idx | 15] - acum[idx]) * dts[idx];
    f32x4 S[8];
#pragma unroll
    for (int st = 0; st < 8; ++st) S[st] = (f32x4){0.f, 0.f, 0.f, 0.f};
#pragma unroll
    for (int kk = 0; kk < 4; ++kk) { const bf16x8 cf = *(const LAS bf16x8*)(Cs + (wid * 16 + fr) * LP + kk * 32 + fq * 8);
#pragma unroll
        for (int st = 0; st < 8; ++st) if (st <= wid) { const bf16x8 bf = *(const LAS bf16x8*)(Bs + (st * 16 + fr) * LP + kk * 32 + fq * 8); S[st] = __builtin_amdgcn_mfma_f32_16x16x32_bf16(bf, cf, S[st], 0, 0, 0); } }
    __syncthreads();
    LAS bf16_t* Pb = Bs;
    const int half = wid >> 2, pt = wid & 3;
    float ssq[4] = {0.f, 0.f, 0.f, 0.f};
    const bf16_t* states = (const bf16_t*)(p.ws + OFF_STATES);
    bf16_t* segA = (bf16_t*)(p.ws + OFF_SEGA);
    bf16x8 pfn[4];
    { const bf16_t* pr = states + ((size_t)((b * NCHUNK + c) * 24 + g * 6) * 64 + pt * 16 + fr) * 128 + fq * 8;
#pragma unroll
      for (int kk = 0; kk < 4; ++kk) pfn[kk] = *(const bf16x8*)(pr + kk * 32);
 }
#pragma unroll 1
    for (int j = 0; j < 6; ++j) {
        const int hp = j >> 1, hs = j & 1, h = g * 6 + j;
        if (hs == 0) { float o[4][8]; int t0, co; conv_compute((const LAS float*)(lds + CW_OFF) + hp * 640, rawA, o, t0, co);
          if (hp < 2) conv_load(p, b, c, (g * 6 + 2 * hp + 2) * 64, rawA);
#pragma unroll
          for (int e = 0; e < 8; ++e) { u32x2 w; w.x = pk2(o[0][e], o[1][e]); w.y = pk2(o[2][e], o[3][e]); *(LAS u32x2*)(XT + tsw_w(co * 8 + e, t0)) = w; } }
        {
            bf16x8 pf[4]; u32x2 zw4[4];
#pragma unroll
            for (int kk = 0; kk < 4; ++kk) pf[kk] = pfn[kk];
#pragma unroll
            for (int q = 0; q < 4; ++q) { const int lt = half == 0 ? (q == 0 ? 0 : (q == 1 ? 3 : (q == 2 ? 4 : 7))) : (q == 0 ? 1 : (q == 1 ? 2 : (q == 2 ? 5 : 6)));
                zw4[q] = *(const u32x2*)(segA + (tok0 + lt * 16 + fr) * LDA_SEG + 1024 + h * 64 + pt * 16 + 4 * fq); }
            if (j < 5) { const bf16_t* pr = states + ((size_t)((b * NCHUNK + c) * 24 + h + 1) * 64 + pt * 16 + fr) * 128 + fq * 8;
#pragma unroll
              for (int kk = 0; kk < 4; ++kk) pfn[kk] = *(const bf16x8*)(pr + kk * 32); }
            {
              const int l = wid * 16 + fr; const float al = acum[j * 128 + l], Dh = p.ssdd[h];
#pragma unroll
              for (int st = 0; st < 8; ++st) if (st <= (wid | 1)) { float v[4];
                  if (st < wid) {
                      const float uu = __expf(al - acum[j * 128 + st * 16 + 15]); const f32x4 v4 = *(const LAS f32x4*)(vtab + j * 128 + st * 16 + 4 * fq);
#pragma unroll
                      for (int jj = 0; jj < 4; ++jj) v[jj] = S[st][jj] * uu * v4[jj];
                  } else {
                      const f32x4 as4 = *(const LAS f32x4*)(acum + j * 128 + st * 16 + 4 * fq), ds4 = *(const LAS f32x4*)(dts + j * 128 + st * 16 + 4 * fq);
#pragma unroll
                      for (int jj = 0; jj < 4; ++jj) { const int sx = st * 16 + 4 * fq + jj; float t = 0.f;
                          if (sx <= l) t = S[st][jj] * __expf(al - as4[jj]) * ds4[jj];
                          if (sx == l) t += Dh; v[jj] = t; } }
                  u32x2 w; w.x = pk2(v[0], v[1]); w.y = pk2(v[2], v[3]); *(LAS u32x2*)(Pb + l * LP + st * 16 + 4 * fq) = w; } }
            __syncthreads();
            bf16x8 xf[4];
#pragma unroll
            for (int kk = 0; kk < 4; ++kk) xf[kk] = *(const LAS bf16x8*)(XT + tsw_r(hs * 64 + pt * 16 + fr, kk * 4 + fq));
            __builtin_amdgcn_s_setprio(1);
#pragma unroll
            for (int q = 0; q < 4; ++q) {
                const int lt = half == 0 ? (q == 0 ? 0 : (q == 1 ? 3 : (q == 2 ? 4 : 7))) : (q == 0 ? 1 : (q == 1 ? 2 : (q == 2 ? 5 : 6)));
                f32x4 ad = (f32x4){0.f, 0.f, 0.f, 0.f}, ao = (f32x4){0.f, 0.f, 0.f, 0.f};
#pragma unroll
                for (int kk = 0; kk < 4; ++kk) if (kk <= (lt >> 1)) { const bf16x8 pfr = *(const LAS bf16x8*)(Pb + (lt * 16 + fr) * LP + kk * 32 + fq * 8); ad = __builtin_amdgcn_mfma_f32_16x16x32_bf16(xf[kk], pfr, ad, 0, 0, 0); }
#pragma unroll
                for (int kk = 0; kk < 4; ++kk) { const bf16x8 cfr = *(const LAS bf16x8*)(Cs + (lt * 16 + fr) * LP + kk * 32 + fq * 8); ao = __builtin_amdgcn_mfma_f32_16x16x32_bf16(pf[kk], cfr, ao, 0, 0, 0); }
                const int l = lt * 16 + fr; const float ea = __expf(acum[j * 128 + l]);
                bf16_t* zp = segA + (tok0 + l) * LDA_SEG + 1024 + h * 64 + pt * 16 + 4 * fq;
                const u32x2 zw = zw4[q];
                const float y0 = (ad[0] + ea * ao[0]) * siluf_(bflo(zw.x)), y1 = (ad[1] + ea * ao[1]) * siluf_(bfhi(zw.x)), y2 = (ad[2] + ea * ao[2]) * siluf_(bflo(zw.y)), y3 = (ad[3] + ea * ao[3]) * siluf_(bfhi(zw.y));
                ssq[q] += (y0 * y0 + y1 * y1) + (y2 * y2 + y3 * y3);
                u32x2 yo; yo.x = pk2(y0, y1); yo.y = pk2(y2, y3); if (!(p.dry & 1)) *(u32x2*)zp = yo;
            }
            __builtin_amdgcn_s_setprio(0);
            __syncthreads();
        }
    }
#pragma unroll
    for (int q = 0; q < 4; ++q) { float s = ssq[q]; s += __shfl_xor(s, 16); s += __shfl_xor(s, 32); if (fq == 0) red[wid * 64 + q * 16 + fr] = s; }
    __syncthreads();
    float rstd[4];
#pragma unroll
    for (int q = 0; q < 4; ++q) { const int o = q * 16 + fr; const float tot = (red[(half * 4 + 0) * 64 + o] + red[(half * 4 + 1) * 64 + o]) + (red[(half * 4 + 2) * 64 + o] + red[(half * 4 + 3) * 64 + o]);
        rstd[q] = rsqrtf(tot * (1.0f / 384.0f) + 1e-6f); }
#pragma unroll
    for (int j = 0; j < 6; ++j) { const int h = g * 6 + j; const f32x4 nw = *(const f32x4*)(p.ssdnw + h * 64 + pt * 16 + 4 * fq);
#pragma unroll
        for (int q = 0; q < 4; ++q) {
            const int lt = half == 0 ? (q == 0 ? 0 : (q == 1 ? 3 : (q == 2 ? 4 : 7))) : (q == 0 ? 1 : (q == 1 ? 2 : (q == 2 ? 5 : 6)));
            const int l = lt * 16 + fr; bf16_t* zp = segA + (tok0 + l) * LDA_SEG + 1024 + h * 64 + pt * 16 + 4 * fq;
            const u32x2 w = *(const u32x2*)zp; u32x2 o;
            o.x = pk2(bflo(w.x) * rstd[q] * nw[0], bfhi(w.x) * rstd[q] * nw[1]); o.y = pk2(bflo(w.y) * rstd[q] * nw[2], bfhi(w.y) * rstd[q] * nw[3]);
            if (!(p.dry & 1)) *(u32x2*)zp = o; } }
    __syncthreads();
}

template <int PASS>
__device__ __forceinline__ void s5_wave_item(const Params& p, LAS float* wl  , int item) {
    const int g = item & 31, c = (item >> 5) & 15, b = item >> 9;
    const int lane = threadIdx.x & 63, fr = lane & 15, fq = lane >> 4;
    const size_t tok0 = (size_t)b * SEQ + c * CH;
    bf16_t* segA = (bf16_t*)(p.ws + OFF_SEGA);
    const float* lam = (const float*)(p.ws + OFF_LAM); const float lr = lam[(g * 64 + lane) * 2], li = lam[(g * 64 + lane) * 2 + 1];
    float* E = (float*)(p.ws + OFF_E);
    bf16x8 bbf[8];
    { const bf16_t* bbt = (const bf16_t*)(p.ws + OFF_BBT) + (size_t)g * 128 * 32;
#pragma unroll
      for (int n = 0; n < 8; ++n) bbf[n] = *(const bf16x8*)(bbt + (n * 16 + fr) * 32 + fq * 8); }
    float sr = 0.f, si = 0.f;
    bf16x8 cwf[4]; f32x4 dv = (f32x4){0.f, 0.f, 0.f, 0.f};
    if (PASS == 2) {
        const float* lamL = (const float*)(p.ws + OFF_LAML); const float Lr = lamL[(g * 64 + lane) * 2], Li = lamL[(g * 64 + lane) * 2 + 1];
        float er[15], ei[15];
#pragma unroll
        for (int cc = 0; cc < 15; ++cc) { er[cc] = 0.f; ei[cc] = 0.f; if (cc < c) { er[cc] = E[(size_t)((b * NCHUNK + cc) * 32 + g) * 128 + lane]; ei[cc] = E[(size_t)((b * NCHUNK + cc) * 32 + g) * 128 + 64 + lane]; } }
#pragma unroll
        for (int cc = 0; cc < 15; ++cc) if (cc < c) { const float nr = Lr * sr - Li * si + er[cc], ni = Lr * si + Li * sr + ei[cc]; sr = nr; si = ni; }
        const bf16_t* cwt = (const bf16_t*)(p.ws + OFF_CWT) + (size_t)g * 16 * 128;
#pragma unroll
        for (int kk = 0; kk < 4; ++kk) cwf[kk] = *(const bf16x8*)(cwt + fr * 128 + kk * 32 + fq * 8);
        dv = *(const f32x4*)(p.s5d + g * 16 + 4 * fq);
    }
    bf16x8 ufa[8]; u32x2 uwa[8];
#pragma unroll
    for (int bt = 0; bt < 8; ++bt) { ufa[bt] = (bf16x8){0, 0, 0, 0, 0, 0, 0, 0}; uwa[bt] = (u32x2){0u, 0u};
        if (fq < 2) ufa[bt] = *(const bf16x8*)(segA + (tok0 + bt * 16 + fr) * LDA_SEG + g * 16 + fq * 8);
        if (PASS == 2) uwa[bt] = *(const u32x2*)(segA + (tok0 + bt * 16 + fr) * LDA_SEG + g * 16 + 4 * fq); }
#pragma unroll
    for (int bt = 0; bt < 8; ++bt) {
        const size_t trow = tok0 + bt * 16 + fr;
        const bf16x8 uf = ufa[bt]; const u32x2 uw = uwa[bt];
        f32x4 bu[8];
#pragma unroll
        for (int n = 0; n < 8; ++n) { bu[n] = (f32x4){0.f, 0.f, 0.f, 0.f}; bu[n] = __builtin_amdgcn_mfma_f32_16x16x32_bf16(bbf[n], uf, bu[n], 0, 0, 0); }
        asm volatile("s_nop 15\n\ts_nop 15" : "+v"(bu[0]), "+v"(bu[1]), "+v"(bu[2]), "+v"(bu[3]), "+v"(bu[4]), "+v"(bu[5]), "+v"(bu[6]), "+v"(bu[7]));
#pragma unroll
        for (int n = 0; n < 8; ++n) *(LAS f32x4*)(wl + fr * 132 + n * 16 + 4 * fq) = bu[n];
        asm volatile("s_waitcnt lgkmcnt(0)" ::: "memory"); __builtin_amdgcn_wave_barrier();
        float br[16], bi[16];
#pragma unroll
        for (int t = 0; t < 16; ++t) { br[t] = wl[t * 132 + lane]; bi[t] = wl[t * 132 + 64 + lane]; }
#pragma unroll
        for (int t = 0; t < 16; ++t) { const float nr = lr * sr - li * si + br[t], ni = lr * si + li * sr + bi[t]; sr = nr; si = ni; br[t] = sr; bi[t] = si; }
        if (PASS == 2) {
#pragma unroll
            for (int t = 0; t < 16; ++t) { wl[t * 132 + lane] = br[t]; wl[t * 132 + 64 + lane] = bi[t]; } }
        if (PASS == 2) {
            asm volatile("s_waitcnt lgkmcnt(0)" ::: "memory"); __builtin_amdgcn_wave_barrier();
            f32x4 a = (f32x4){0.f, 0.f, 0.f, 0.f};
#pragma unroll
            for (int kk = 0; kk < 4; ++kk) { const f32x4 s0 = *(const LAS f32x4*)(wl + fr * 132 + kk * 32 + fq * 8), s1 = *(const LAS f32x4*)(wl + fr * 132 + kk * 32 + fq * 8 + 4);
                u32x4 w; w.x = pk2(s0[0], s0[1]); w.y = pk2(s0[2], s0[3]); w.z = pk2(s1[0], s1[1]); w.w = pk2(s1[2], s1[3]);
                bf16x8 sf; __builtin_memcpy(&sf, &w, 16);
                a = __builtin_amdgcn_mfma_f32_16x16x32_bf16(cwf[kk], sf, a, 0, 0, 0); }
            bf16_t* up = segA + trow * LDA_SEG + g * 16 + 4 * fq;
            const float y0 = geluf_(a[0] + dv[0] * bflo(uw.x)), y1 = geluf_(a[1] + dv[1] * bfhi(uw.x)), y2 = geluf_(a[2] + dv[2] * bflo(uw.y)), y3 = geluf_(a[3] + dv[3] * bfhi(uw.y));
            u32x2 o; o.x = pk2(y0, y1); o.y = pk2(y2, y3); if (!(p.dry & 2)) *(u32x2*)up = o;
            asm volatile("s_waitcnt lgkmcnt(0)" ::: "memory"); __builtin_amdgcn_wave_barrier();
        }
    }
    if (PASS == 1) { E[(size_t)((b * NCHUNK + c) * 32 + g) * 128 + lane] = sr; E[(size_t)((b * NCHUNK + c) * 32 + g) * 128 + 64 + lane] = si; }
}

#define XB_TMO      128
#define XB_XCNT(j)  (256  + 64 * (j))
#define XB_XSUB(j)  (1280 + 64 * (j))
#define XB_XGEN(j)  (2304 + 64 * (j))
#define XB_TOP      3328
#define XB_TOPGEN   3392
#define XCD_BAR_WORDS 3456
#define XB_SPIN_CAP (1u << 18)
__device__ __forceinline__ unsigned xb_ld(unsigned* p)              { return __hip_atomic_load(p, __ATOMIC_RELAXED, __HIP_MEMORY_SCOPE_AGENT); }
__device__ __forceinline__ unsigned xb_add(unsigned* p, unsigned v) { return __hip_atomic_fetch_add(p, v, __ATOMIC_RELAXED, __HIP_MEMORY_SCOPE_AGENT); }
__device__ __forceinline__ unsigned xb_xcc_id() { return (unsigned)__builtin_amdgcn_s_getreg((3 << 11) | 20) & 0xFu; }
#define XB_SPIN(cond, bar) do { unsigned _sp = 0; while (cond) { __builtin_amdgcn_s_sleep(1); \
    if ((++_sp & 255u) == 0u) { if (xb_ld(&(bar)[XB_TMO])) break; if (_sp > XB_SPIN_CAP) { atomicAdd(&(bar)[XB_TMO], 1u); break; } } } } while (0)
struct XcdBarrier { unsigned* bar; unsigned x; volatile LAS unsigned* st; };
__device__ __forceinline__ XcdBarrier xcd_barrier_post(unsigned* bar, volatile LAS unsigned* st) {
    XcdBarrier b; b.bar = bar; b.x = xb_xcc_id(); b.st = st;
    if (threadIdx.x == 0) (void)xb_add(&bar[XB_XCNT(b.x)], 1u);
    return b;
}
__device__ __forceinline__ void xcd_barrier_complete(unsigned* bar, unsigned x, unsigned& nloc, unsigned& nx) {
    const unsigned G = gridDim.x * gridDim.y * gridDim.z;
    unsigned sum, cnt, mine, sp = 0u;
    for (;;) {
        sum = 0u; cnt = 0u; mine = 0u;
#pragma unroll
        for (unsigned j = 0; j < 16; ++j) { const unsigned c = xb_ld(&bar[XB_XCNT(j)]); sum += c; cnt += (c > 0u) ? 1u : 0u; mine = (j == x) ? c : mine; }
        if (sum == G) break;
        __builtin_amdgcn_s_sleep(1);
        if ((++sp & 255u) == 0u) { if (xb_ld(&bar[XB_TMO])) break; if (sp > XB_SPIN_CAP) { atomicAdd(&bar[XB_TMO], 1u); break; } }
    }
    nloc = mine > 0u ? mine : 1u; nx = cnt > 0u ? cnt : 1u;
}
__device__ __forceinline__ void xcd_barrier(const XcdBarrier& b) {
    asm volatile("s_waitcnt vmcnt(0)" ::: "memory");
    __syncthreads();
    if (threadIdx.x == 0) {
        unsigned* bar = b.bar;
        __builtin_amdgcn_s_waitcnt(0);
        unsigned nloc = b.st[0], nx = b.st[1];
        if (nloc == 0u) { xcd_barrier_complete(bar, b.x, nloc, nx); b.st[0] = nloc; b.st[1] = nx; }
        const unsigned old = xb_add(&bar[XB_XSUB(b.x)], 1u);
        const unsigned gen = old / nloc;
        if (old + 1u == (gen + 1u) * nloc) {
            __builtin_amdgcn_fence(__ATOMIC_RELEASE, "agent");
            asm volatile("s_waitcnt vmcnt(0)" ::: "memory");
            const unsigned og = xb_add(&bar[XB_TOP], 1u);
            const unsigned tg = og / nx;
            if (og + 1u == (tg + 1u) * nx) xb_add(&bar[XB_TOPGEN], 1u);
            else XB_SPIN(xb_ld(&bar[XB_TOPGEN]) == tg, bar);
            __builtin_amdgcn_fence(__ATOMIC_ACQUIRE, "agent");
            xb_add(&bar[XB_XGEN(b.x)], 1u);
            asm volatile("s_waitcnt vmcnt(0)" ::: "memory");
        } else {
            XB_SPIN(xb_ld(&bar[XB_XGEN(b.x)]) == gen, bar);
            __builtin_amdgcn_fence(__ATOMIC_ACQUIRE, "agent");
            asm volatile("s_waitcnt vmcnt(0)" ::: "memory");
        }
    }
    __syncthreads();
}

__global__ void __launch_bounds__(512) mega(Params p) {
    extern __shared__ __attribute__((aligned(16))) unsigned char lds_raw[];
    LAS unsigned char* lds = (LAS unsigned char*)lds_raw;
    cg::grid_group grid = cg::this_grid();
    const int lo = p.ph_lo, hi = p.ph_hi, G = gridDim.x, wg = blockIdx.x, tid = threadIdx.x, wid = tid >> 6;
    unsigned char* ws = p.ws;
#ifndef ONLY
#define ONLY -1
#endif
#define IN(k) ((ONLY < 0 || ONLY == (k)) && lo <= (k) && (k) <= hi)
#define SEAM(k) do { if (lo <= (k) && (k) < hi) xcd_barrier(xb); } while (0)
    if (lo < 0) grid.sync();
    XcdBarrier xb; xb.bar = (unsigned*)(ws + OFF_BAR); xb.x = 0; xb.st = (volatile LAS unsigned*)(lds + 131072);
    if (lo < hi) {
        if (tid < 2) xb.st[tid] = 0u;
        __syncthreads();
        xb = xcd_barrier_post((unsigned*)(ws + OFF_BAR), (volatile LAS unsigned*)(lds + 131072));
    }
    if (IN(0)) phase0(p, lds);
    SEAM(0);
    if (IN(1)) {
        {
            const int lane = tid & 63, fr = lane & 15, fq = lane >> 4;
            const bf16_t* xn = (const bf16_t*)(ws + OFF_XN); const bf16_t* wdt = (const bf16_t*)(ws + OFF_WDT); float* dtv = (float*)(ws + OFF_DTV);
            for (int rt = wg * 8 + wid; rt < T_TOK / 16; rt += G * 8) {
                f32x4 a0 = (f32x4){0.f, 0.f, 0.f, 0.f}, a1 = a0;
                const bf16_t* xr = xn + (size_t)(rt * 16 + fr) * 1024 + fq * 8; const bf16_t* w0 = wdt + (size_t)fr * 1024 + fq * 8; const bf16_t* w1 = w0 + 16 * 1024;
#pragma unroll 8
                for (int kk = 0; kk < 32; ++kk) { const bf16x8 xa = *(const bf16x8*)(xr + kk * 32), b0 = *(const bf16x8*)(w0 + kk * 32), b1 = *(const bf16x8*)(w1 + kk * 32);
                    a0 = __builtin_amdgcn_mfma_f32_16x16x32_bf16(b0, xa, a0, 0, 0, 0); a1 = __builtin_amdgcn_mfma_f32_16x16x32_bf16(b1, xa, a1, 0, 0, 0); }
                float* dr = dtv + (size_t)(rt * 16 + fr) * 24 + 4 * fq; f32x4 o0, o1;
#pragma unroll
                for (int j = 0; j < 4; ++j) { o0[j] = softplusf_(a0[j] + p.dtbias[4 * fq + j]); o1[j] = softplusf_(a1[j] + p.dtbias[(16 + 4 * fq + j) % 24]); }
                *(f32x4*)dr = o0; if (fq < 2) *(f32x4*)(dr + 16) = o1;
            }
        }
        pg8::Gemm g{(const bf16_t*)(ws + OFF_XN), (const bf16_t*)(ws + OFF_WIN), 1024, 1024, T_TOK, N_INP, 1024}; pg8::StaticOrder S; S.init(T_TOK, N_INP, G, wg);
        EpiInProj E{(bf16_t*)(ws + OFF_SEGA), (bf16_t*)(ws + OFF_SEGB), (bf16_t*)p.out, (float*)(ws + OFF_DTV), p.dtbias, p.dry};
        pg8::gemm_phase(lds, g, S, E);
    }
    SEAM(1);
    if (IN(2)) {
        if (!(p.dry & 32)) for (int it = wg; it < 1024; it += G) { if (it == wg || (G & 3)) conv_fill(p, lds, it & 3); ssd_states_item(p, lds, it); }
        for (int it = wg * 8 + wid; it < 8192; it += G * 8) if (((it >> 5) & 15) != 15) s5_wave_item<1>(p, (LAS float*)(lds + wid * 8448), it);
    }
    SEAM(2);
    if (IN(3)) {
        const bool s5first = (wg & 1) != 0;
        if (!s5first) ssd_prefix(p);
        for (int it = wg * 8 + wid; it < 8192; it += G * 8) s5_wave_item<2>(p, (LAS float*)(lds + wid * 8448), it);
        if (s5first) ssd_prefix(p);
        __syncthreads();
        xpose_tiles<0>(p.wbr5, 1024, 512, (bf16_t*)(ws + OFF_W5T), 1024, nullptr, (LAS float*)lds, wg, G);
        xpose_tiles<0>(p.wbrs, 1024, 1536, (bf16_t*)(ws + OFF_WSST), 1024, nullptr, (LAS float*)lds, wg, G);
        xpose_tiles<0>(p.wout, 1024, 1024, (bf16_t*)(ws + OFF_WOUTT), 1024, nullptr, (LAS float*)lds, wg, G);
        xpose_tiles<0>(p.wpg, 1024, 1024, (bf16_t*)(ws + OFF_WPGT), 1024, p.plenw, (LAS float*)lds, wg, G);
        xpose_tiles<0>(p.wpp, 1024, 256, (bf16_t*)(ws + OFF_WPPT), 1024, nullptr, (LAS float*)lds, wg, G);
        { bf16_t* pbf = (bf16_t*)(ws + OFF_PBF); const int nthr = G * 512;
          for (int v = wg * 512 + tid; v < T_TOK * 256 / 8; v += nthr) { const f32x4 a = *(const f32x4*)(p.p + (size_t)v * 8), bq = *(const f32x4*)(p.p + (size_t)v * 8 + 4);
              u32x4 w; w.x = pk2(a[0], a[1]); w.y = pk2(a[2], a[3]); w.z = pk2(bq[0], bq[1]); w.w = pk2(bq[2], bq[3]); *(u32x4*)(pbf + (size_t)v * 8) = w; } }
    }
    SEAM(3);
    if (IN(4)) {
#ifndef NO_SSD_OUT
        if (p.dry != 2) for (int it = wg; it < 1024; it += G) { if (it == wg || (G & 3)) conv_fill(p, lds, it & 3); ssd_out_item(p, lds, it); }
#endif
    }
    SEAM(4);
    if (IN(5)) {
        { pg8::Gemm g{(const bf16_t*)(ws + OFF_SEGA), (const bf16_t*)(ws + OFF_WGLU), LDA_SEG, 512, T_TOK, 512, 512}; pg8::StaticOrder S; S.init(T_TOK, 512, G, wg);
          EpiGlu E{(bf16_t*)(ws + OFF_SEGA), p.bglu}; pg8::gemm_phase(lds, g, S, E); }
    }
    SEAM(5);
    if (IN(6)) {
        { pg8::Gemm g{(const bf16_t*)(ws + OFF_SEGA) + 512, (const bf16_t*)(ws + OFF_W5T), LDA_SEG, 512, T_TOK, 1024, 512}; pg8::StaticOrder S; S.init(T_TOK, 1024, G, wg);
          EpiMerge<0> E{(bf16_t*)(ws + OFF_M5), (const bf16_t*)p.out, nullptr}; pg8::gemm_phase(lds, g, S, E); }
        { pg8::Gemm g{(const bf16_t*)(ws + OFF_SEGA) + 1024, (const bf16_t*)(ws + OFF_WSST), LDA_SEG, 1536, T_TOK, 1024, 1536}; pg8::StaticOrder S; S.init(T_TOK, 1024, G, wg);
          EpiMerge<1> E{(bf16_t*)(ws + OFF_MERGED), (const bf16_t*)p.out, (const bf16_t*)(ws + OFF_M5)}; pg8::gemm_phase(lds, g, S, E); }
    }
    SEAM(6);
    if (IN(7)) {
        pg8::Gemm g{(const bf16_t*)(ws + OFF_MERGED), (const bf16_t*)(ws + OFF_WOUTT), 1024, 1024, T_TOK, 1024, 1024}; pg8::StaticOrder S; S.init(T_TOK, 1024, G, wg);
        EpiOut E{p.x, (bf16_t*)(ws + OFF_M5), (float*)(ws + OFF_SS1)}; pg8::gemm_phase(lds, g, S, E);
    }
    SEAM(7);
    if (IN(8)) {
        { pg8::Gemm g{(const bf16_t*)(ws + OFF_PBF), (const bf16_t*)(ws + OFF_WPPT), 256, 256, T_TOK, 1024, 256}; pg8::StaticOrder S; S.init(T_TOK, 1024, G, wg);
          EpiMerge<2> E{(bf16_t*)(ws + OFF_PLEP), nullptr, nullptr}; pg8::gemm_phase(lds, g, S, E); }
        { pg8::Gemm g{(const bf16_t*)(ws + OFF_M5), (const bf16_t*)(ws + OFF_WPGT), 1024, 1024, T_TOK, 1024, 1024}; pg8::StaticOrder S; S.init(T_TOK, 1024, G, wg);
          EpiPle E{(const bf16_t*)(ws + OFF_M5), (bf16_t*)(ws + OFF_SEGA), (const bf16_t*)(ws + OFF_PLEP), (const float*)(ws + OFF_SS1), (float*)(ws + OFF_SS2)}; pg8::gemm_phase(lds, g, S, E); }
    }
    SEAM(8);
    if (IN(9)) {
        const int lane = tid & 63; const float* ss2 = (const float*)(ws + OFF_SS2);
        for (int row0 = (wg * 8 + wid) * 2; row0 < T_TOK; row0 += G * 16) {
            u32x2 hw[2][4]; float r[2];
#pragma unroll
            for (int rr = 0; rr < 2; ++rr) { const u32x2* hp2 = (const u32x2*)((const bf16_t*)(ws + OFF_SEGA) + (size_t)(row0 + rr) * DM);
#pragma unroll
                for (int i = 0; i < 4; ++i) hw[rr][i] = hp2[lane + 64 * i];
                float s = lane < 16 ? ss2[(size_t)(row0 + rr) * 16 + lane] : 0.f; s = wave_sum(s); r[rr] = rsqrtf(s * (1.0f / 1024.0f) + 1e-6f); }
#pragma unroll
            for (int i = 0; i < 4; ++i) { const f32x4 w = ((const f32x4*)p.fnw)[lane + 64 * i];
#pragma unroll
                for (int rr = 0; rr < 2; ++rr) { f32x4 v; v[0] = bflo(hw[rr][i].x) * r[rr] * w[0]; v[1] = bfhi(hw[rr][i].x) * r[rr] * w[1]; v[2] = bflo(hw[rr][i].y) * r[rr] * w[2]; v[3] = bfhi(hw[rr][i].y) * r[rr] * w[3];
                    ((f32x4*)(p.out + (size_t)(row0 + rr) * DM))[lane + 64 * i] = v; } }
        }
    }
#undef IN
#undef SEAM
}

#ifndef N_LAUNCH_MODE
#define N_LAUNCH_MODE 1
#endif
extern "C" void kernel_launch(void* const* d_in, const int* in_sizes, int n_in, void* d_out, int out_size, void* d_ws, size_t ws_size, hipStream_t stream) {
    static int grid = 0;
    if (grid == 0) {
        if (n_in != 27 || ws_size < WS_NEED) { fprintf(stderr, "kernel_launch: need 27 inputs and >= %zu bytes of workspace; got %d, %zu\n", (size_t)WS_NEED, n_in, ws_size); grid = -1; return; }
        int dev = 0, cus = 0, per_cu = 0;
        hipGetDevice(&dev); hipDeviceGetAttribute(&cus, hipDeviceAttributeMultiprocessorCount, dev);
        if (hipFuncSetAttribute((const void*)mega, hipFuncAttributeMaxDynamicSharedMemorySize, LDS_BYTES) != hipSuccess) { fprintf(stderr, "kernel_launch: hipFuncSetAttribute failed\n"); grid = -1; return; }
        if (hipOccupancyMaxActiveBlocksPerMultiprocessor(&per_cu, (const void*)mega, 512, LDS_BYTES) != hipSuccess || per_cu < 1) { fprintf(stderr, "kernel_launch: occupancy query says %d blocks per CU\n", per_cu); per_cu = 1; }
        (void)hipGetLastError();
        grid = cus;
    }
    if (grid < 0) return;
    Params p{};
    const float** pp = (const float**)&p;
    for (int i = 0; i < 27; ++i) pp[i] = (const float*)d_in[i];
    p.out = (float*)d_out; p.ws = (unsigned char*)d_ws;
#if N_LAUNCH_MODE == 1
    hipMemsetAsync((unsigned char*)d_ws + OFF_BAR, 0, XCD_BAR_WORDS * 4, stream);
    p.ph_lo = 0; p.ph_hi = 9;
    void* args[] = {&p};
    hipError_t e = hipLaunchCooperativeKernel((const void*)mega, dim3(grid), dim3(512), args, LDS_BYTES, stream);
    if (e != hipSuccess) fprintf(stderr, "cooperative launch failed: %s (grid %d)\n", hipGetErrorString(e), grid);
#else
#ifndef PROBE_DUP2
#define PROBE_DUP2 -1
#endif
#ifndef PROBE_DUP
#define PROBE_DUP -1
#endif
#ifndef PROBE_DRY4
#define PROBE_DRY4 0
#endif
    for (int k = 0; k < 10; ++k) { p.ph_lo = k; p.ph_hi = k;
#ifndef PROBE_DRY1
#define PROBE_DRY1 0
#endif
#ifndef PROBE_DRY2
#define PROBE_DRY2 0
#endif
        if (k == 2 && PROBE_DRY2) { p.dry = 32; hipLaunchKernelGGL(mega, dim3(grid), dim3(512), LDS_BYTES, stream, p); p.dry = 0; }
        if (k == 1 && PROBE_DRY1) { p.dry = 4; hipLaunchKernelGGL(mega, dim3(grid), dim3(512), LDS_BYTES, stream, p); p.dry = 0; }
        if (k == 4 && PROBE_DRY4) { p.dry = PROBE_DRY4; hipLaunchKernelGGL(mega, dim3(grid), dim3(512), LDS_BYTES, stream, p); p.dry = 0; }
        hipLaunchKernelGGL(mega, dim3(grid), dim3(512), LDS_BYTES, stream, p);
        if (k == PROBE_DUP || k == PROBE_DUP2) hipLaunchKernelGGL(mega, dim3(grid), dim3(512), LDS_BYTES, stream, p); }
#endif
}
```

```cpp
#include <hip/hip_runtime.h>
#include <hip/hip_cooperative_groups.h>
#include <cstdio>
namespace cg = cooperative_groups;

#define LAS __attribute__((address_space(3)))
typedef unsigned short bf16_t;
typedef short bf16x8 __attribute__((ext_vector_type(8)));
typedef float f32x4 __attribute__((ext_vector_type(4)));
typedef float f32x2 __attribute__((ext_vector_type(2)));
typedef unsigned u32x4 __attribute__((ext_vector_type(4)));
typedef unsigned u32x2 __attribute__((ext_vector_type(2)));

constexpr int T_TOK = 32768, DM = 1024, SEQ = 2048, NBATCH = 16, NCHUNK = 16, CH = 128;
constexpr int LDA_SEG = 2560;
constexpr int N_INP = 7168;
constexpr size_t MiB = 1ull << 20;
constexpr size_t OFF_SEGA = 0;
constexpr size_t OFF_SEGB = 160 * MiB;
constexpr size_t OFF_STATES = 320 * MiB;
constexpr size_t OFF_XN = 416 * MiB;
constexpr size_t OFF_WIN = 480 * MiB;
constexpr size_t OFF_DTV = 495 * MiB;
constexpr size_t OFF_E = 498 * MiB;
constexpr size_t OFF_TAB = 502 * MiB;
constexpr size_t OFF_WGLU = OFF_TAB;
constexpr size_t OFF_LAM = OFF_TAB + 512 * 1024;
constexpr size_t OFF_LAML = OFF_LAM + 16 * 1024;
constexpr size_t OFF_BBT = OFF_LAML + 16 * 1024;
constexpr size_t OFF_CWT = OFF_BBT + 256 * 1024;
constexpr size_t OFF_CDEC = OFF_CWT + 128 * 1024;
constexpr size_t OFF_BAR = OFF_CDEC + 32 * 1024;
constexpr size_t OFF_WDT = OFF_BAR + 16 * 1024;
constexpr size_t WS_NEED = 504 * MiB;
constexpr size_t OFF_M5 = OFF_SEGB;
constexpr size_t OFF_MERGED = OFF_SEGB + 64 * MiB;
constexpr size_t OFF_PBF = OFF_XN + 8 * MiB;
constexpr size_t OFF_W5T = OFF_XN + 24 * MiB;
constexpr size_t OFF_WSST = OFF_XN + 25 * MiB;
constexpr size_t OFF_WOUTT = OFF_XN + 28 * MiB;
constexpr size_t OFF_WPGT = OFF_XN + 30 * MiB;
constexpr size_t OFF_WPPT = OFF_XN + 32 * MiB;
constexpr size_t OFF_PLEP = OFF_STATES;
constexpr size_t OFF_SS1 = OFF_XN;
constexpr size_t OFF_SS2 = OFF_XN + 2 * MiB;

constexpr int LDS_BYTES = 131072 + 16;

struct Params {
    const float *x, *p, *norm_w, *w_in, *a_re, *a_im, *b_re, *b_im, *c_re, *c_im, *s5d, *logstep, *wglu, *bglu,
        *convw, *convb, *dtbias, *alog, *ssdd, *ssdnw, *wbr5, *wbrs, *wout, *plenw, *wpg, *wpp, *fnw;
    float* out; unsigned char* ws; int ph_lo, ph_hi, dry, pad;
};

typedef __bf16 bf16x2_t __attribute__((ext_vector_type(2)));
__device__ __forceinline__ unsigned pk2(float lo, float hi) { f32x2 v = {lo, hi}; bf16x2_t r = __builtin_convertvector(v, bf16x2_t); unsigned u; __builtin_memcpy(&u, &r, 4); return u; }
__device__ __forceinline__ float bflo(unsigned w) { return __uint_as_float(w << 16); }
__device__ __forceinline__ float bfhi(unsigned w) { return __uint_as_float(w & 0xffff0000u); }
__device__ __forceinline__ float sigmoidf_(float v) { return __builtin_amdgcn_rcpf(1.0f + __expf(-v)); }
__device__ __forceinline__ float siluf_(float v) { return v * __builtin_amdgcn_rcpf(1.0f + __expf(-v)); }
__device__ __forceinline__ float softplusf_(float v) { return fmaxf(v, 0.f) + log1pf(__expf(-fabsf(v))); }
__device__ __forceinline__ float geluf_(float v) { const float u = 0.7978845608028654f * (v + 0.044715f * v * v * v); const float t = 1.0f - 2.0f * __builtin_amdgcn_rcpf(1.0f + __expf(2.0f * u)); return 0.5f * v * (1.0f + t); }
__device__ __forceinline__ float wave_sum(float s) {
#pragma unroll
    for (int o = 32; o > 0; o >>= 1) s += __shfl_xor(s, o);
    return s;
}
__device__ __forceinline__ void unpack8(const u32x4 w, float (&f)[8]) { f[0] = bflo(w.x); f[1] = bfhi(w.x); f[2] = bflo(w.y); f[3] = bfhi(w.y); f[4] = bflo(w.z); f[5] = bfhi(w.z); f[6] = bflo(w.w); f[7] = bfhi(w.w); }
__device__ __forceinline__ u32x4 pack8(const float (&f)[8]) { u32x4 w; w.x = pk2(f[0], f[1]); w.y = pk2(f[2], f[3]); w.z = pk2(f[4], f[5]); w.w = pk2(f[6], f[7]); return w; }

namespace pg8 {
constexpr int BM = 256, BK = 64, HALF = 128, HTB = HALF * BK * 2, STAGE_BYTES = 8 * HTB, NXCD = 8, WGM = 8;
__device__ __forceinline__ int lds_byte(int r, int c) { const int st = (r >> 4) * 2 + (c >> 5), rr = r & 15, cc = c & 31, ob = rr * 64 + cc * 2; return st * 1024 + (ob ^ (((ob >> 9) & 1) << 5)); }
__device__ __forceinline__ void stage_rc(int b, int& R, int& C) { const int st = b / 1024, sb = b % 1024, swz = sb ^ (((sb >> 9) & 1) << 5); R = (st >> 1) * 16 + swz / 64; C = (st & 1) * 32 + (swz % 64) / 2; }
__device__ __forceinline__ int perm32(int rho) { const int n = rho >> 4, i = rho & 15; return 8 * (i >> 2) + 4 * n + (i & 3); }
struct Unit { int pm, pn; };
struct Gemm { const bf16_t* A; const bf16_t* Bt; int lda, ldb, M, N, K; };
struct StaticOrder {
    int nM, nN, nwg, G, c;
    __device__ void init(int M, int N, int G_, int c_) { nM = M / BM; nN = N / BM; nwg = nM * nN; G = G_; c = c_; }
    __device__ bool next(int i, Unit& u) const {
        const long L = (long)i * G + c; if (L >= nwg) return false;
        int wgid = (int)L; { const int q = nwg / NXCD, r = nwg % NXCD, xcd = wgid % NXCD, off = wgid / NXCD; wgid = (xcd < r ? xcd * (q + 1) : r * (q + 1) + (xcd - r) * q) + off; }
        const int nig = WGM * nN, gid = wgid / nig, fm = gid * WGM, gsz = (nM - fm) < WGM ? (nM - fm) : WGM;
        u.pm = fm + ((wgid % nig) % gsz); u.pn = (wgid % nig) / gsz; return true;
    }
};
template <class Epi>
__device__ __forceinline__ void gemm_phase(LAS unsigned char* lds, const Gemm g, const StaticOrder& S, const Epi& E) {
    const int tid = threadIdx.x, wid = __builtin_amdgcn_readfirstlane(tid >> 6), lane = tid & 63, wr = wid >> 2, wc = wid & 3, fr = lane & 15, fq = lane >> 4;
    const int K = g.K, nt = K / BK;
    unsigned voffA[2], voffB[2];
#pragma unroll
    for (int i = 0; i < 2; ++i) { int R, C; stage_rc(tid * 16 + i * 8192, R, C); const int Rb = (R & ~31) + perm32(R & 31);
        voffA[i] = (unsigned)(R * g.lda + C) * 2u; voffB[i] = (unsigned)(Rb * g.ldb + C) * 2u; }
    const size_t kstep = (size_t)(BK * 2);
    const size_t hstepA = (size_t)HALF * g.lda * 2, hstepB = (size_t)HALF * g.ldb * 2;
    const size_t tstepA = 2 * hstepA, tstepB = 2 * hstepB;
    const unsigned ldsw = (unsigned)wid * 1024u;
    const int aoff = lds_byte(wr * 64 + fr, fq * 8), boff = lds_byte(wc * 32 + fr, fq * 8);
#define PG8_SA(b, h) (((b) * 2 + (h)) * HTB)
#define PG8_SB(b, h) ((4 + (b) * 2 + (h)) * HTB)
#define PG8_STAGE(bufoff, gbase, voff) do { _Pragma("unroll") for (int _i = 0; _i < 2; ++_i) \
        __builtin_amdgcn_global_load_lds((const unsigned*)((const char*)(gbase) + (voff)[_i]), (LAS unsigned*)(lds + (bufoff) + ldsw + _i * 8192), 16, 0, 0); } while (0)
#define PG8_LDA(dst, b, h) do { _Pragma("unroll") for (int m = 0; m < 4; ++m) _Pragma("unroll") for (int k = 0; k < 2; ++k) dst[m][k] = *(const LAS bf16x8*)(lds + PG8_SA(b, h) + aoff + m * 2048 + k * 1024); } while (0)
#define PG8_LDB(dst, b, h) do { _Pragma("unroll") for (int n = 0; n < 2; ++n) _Pragma("unroll") for (int k = 0; k < 2; ++k) dst[n][k] = *(const LAS bf16x8*)(lds + PG8_SB(b, h) + boff + n * 2048 + k * 1024); } while (0)
#define PG8_MMA(ai, bj, At, Bt) do { __builtin_amdgcn_s_setprio(1); _Pragma("unroll") for (int m = 0; m < 4; ++m) _Pragma("unroll") for (int n = 0; n < 2; ++n) _Pragma("unroll") for (int k = 0; k < 2; ++k) \
        acc[ai][bj][m][n] = __builtin_amdgcn_mfma_f32_16x16x32_bf16(Bt[n][k], At[m][k], acc[ai][bj][m][n], 0, 0, 0); __builtin_amdgcn_s_setprio(0); } while (0)
#define PG8_WAIT_V(n) asm volatile("s_waitcnt vmcnt(" #n ")" ::: "memory")
#define PG8_WAIT_L(n) asm volatile("s_waitcnt lgkmcnt(" #n ")" ::: "memory")
#define PG8_BAR __builtin_amdgcn_s_barrier()
#define PG8_SCHED __builtin_amdgcn_sched_barrier(0)
    Unit cur, nxt; int ui = 0;
    if (!S.next(0, cur)) return;
    f32x4 acc[2][2][4][2];
#pragma unroll
    for (int a = 0; a < 2; ++a)
#pragma unroll
        for (int b = 0; b < 2; ++b)
#pragma unroll
            for (int m = 0; m < 4; ++m)
#pragma unroll
                for (int n = 0; n < 2; ++n) acc[a][b][m][n] = (f32x4){0.f, 0.f, 0.f, 0.f};
    bf16x8 At[4][2], B0[2][2], B1[2][2];
    const char* cA = (const char*)g.A + (size_t)cur.pm * tstepA; const char* cB = (const char*)g.Bt + (size_t)cur.pn * tstepB;
    PG8_STAGE(PG8_SB(0, 0), cB, voffB); PG8_STAGE(PG8_SA(0, 0), cA, voffA); PG8_STAGE(PG8_SB(0, 1), cB + hstepB, voffB); PG8_STAGE(PG8_SA(0, 1), cA + hstepA, voffA);
    if (wr == 1) PG8_BAR;
    PG8_WAIT_V(4); PG8_BAR;
    PG8_STAGE(PG8_SB(1, 0), cB + kstep, voffB); PG8_STAGE(PG8_SA(1, 0), cA + kstep, voffA); PG8_STAGE(PG8_SB(1, 1), cB + hstepB + kstep, voffB);
    PG8_WAIT_V(6); PG8_BAR;
    for (;;) {
        const bool has_next = S.next(ui + 1, nxt);
        const char* nA = has_next ? (const char*)g.A + (size_t)nxt.pm * tstepA : cA; const char* nB = has_next ? (const char*)g.Bt + (size_t)nxt.pn * tstepB : cB;
        for (int t = 0; t < nt; t += 2) {
            const bool last = (t == nt - 2);
            const char* a1 = cA + (size_t)(t + 1) * kstep;
            const char* a2 = last ? nA : cA + (size_t)(t + 2) * kstep; const char* b2 = last ? nB : cB + (size_t)(t + 2) * kstep;
            const char* a3 = a2 + kstep; const char* b3 = b2 + kstep;
            PG8_LDB(B0, 0, 0); PG8_SCHED; PG8_LDA(At, 0, 0); PG8_STAGE(PG8_SA(1, 1), a1 + hstepA, voffA);
            PG8_WAIT_L(8); PG8_BAR; PG8_WAIT_L(0); PG8_MMA(0, 0, At, B0); PG8_BAR; PG8_SCHED;
            PG8_LDB(B1, 0, 1); PG8_STAGE(PG8_SB(0, 0), b2, voffB);
            PG8_BAR; PG8_WAIT_L(0); PG8_MMA(0, 1, At, B1); PG8_BAR;
            PG8_LDA(At, 0, 1); PG8_STAGE(PG8_SA(0, 0), a2, voffA);
            PG8_BAR; PG8_WAIT_L(0); PG8_MMA(1, 0, At, B0); PG8_BAR; PG8_SCHED;
            PG8_STAGE(PG8_SB(0, 1), b2 + hstepB, voffB);
            PG8_WAIT_V(6); PG8_BAR; PG8_MMA(1, 1, At, B1); PG8_BAR;
            PG8_LDB(B0, 1, 0); PG8_SCHED; PG8_LDA(At, 1, 0); PG8_STAGE(PG8_SA(0, 1), a2 + hstepA, voffA);
            PG8_WAIT_L(8); PG8_BAR; PG8_WAIT_L(0); PG8_MMA(0, 0, At, B0); PG8_BAR; PG8_SCHED;
            PG8_LDB(B1, 1, 1); PG8_STAGE(PG8_SB(1, 0), b3, voffB);
            PG8_BAR; PG8_WAIT_L(0); PG8_MMA(0, 1, At, B1); PG8_BAR;
            PG8_LDA(At, 1, 1); PG8_STAGE(PG8_SA(1, 0), a3, voffA);
            PG8_BAR; PG8_WAIT_L(0); PG8_MMA(1, 0, At, B0); PG8_BAR; PG8_SCHED;
            PG8_STAGE(PG8_SB(1, 1), b3 + hstepB, voffB);
            PG8_WAIT_V(6); PG8_BAR; PG8_MMA(1, 1, At, B1); PG8_BAR;
        }
        E(acc, cur, wr, wc, fr, fq);
        if (!has_next) break;
#pragma unroll
        for (int a = 0; a < 2; ++a)
#pragma unroll
            for (int b = 0; b < 2; ++b)
#pragma unroll
                for (int m = 0; m < 4; ++m)
#pragma unroll
                    for (int n = 0; n < 2; ++n) acc[a][b][m][n] = (f32x4){0.f, 0.f, 0.f, 0.f};
        cur = nxt; cA = nA; cB = nB; ++ui;
    }
    PG8_WAIT_V(0);
    if (wr == 0) PG8_BAR;
    PG8_BAR;
#undef PG8_SA
#undef PG8_SB
#undef PG8_STAGE
#undef PG8_LDA
#undef PG8_LDB
#undef PG8_MMA
#undef PG8_WAIT_V
#undef PG8_WAIT_L
#undef PG8_BAR
#undef PG8_SCHED
}
}
typedef f32x4 AccT[2][2][4][2];

struct EpiInProj {
    bf16_t *segA, *segB, *gates; float* dtv; const float* dtbias; int dry;
    __device__ __forceinline__ void operator()(const AccT& acc, const pg8::Unit& u, int wr, int wc, int fr, int fq) const {
        if (dry & 4) return;
        const int pn = u.pn, row0 = u.pm * 256 + wr * 64 + fr;
        {
            bf16_t* base; int ld, colt, act;
            if (pn < 10) { base = segA; ld = LDA_SEG; colt = pn * 256; act = 0; }
            else if (pn < 20) { base = segB; ld = LDA_SEG; colt = (pn - 10) * 256; act = 0; }
            else { base = gates; ld = 2048; colt = (pn - 20) * 256; act = 2; }
            const int col0 = colt + wc * 32 + 8 * fq;
#pragma unroll
            for (int ai = 0; ai < 2; ++ai)
#pragma unroll
                for (int m = 0; m < 4; ++m) { bf16_t* rowp = base + (size_t)(row0 + ai * 128 + m * 16) * ld + col0;
#pragma unroll
                    for (int bj = 0; bj < 2; ++bj) { f32x4 v0 = acc[ai][bj][m][0], v1 = acc[ai][bj][m][1];
                        if (act == 1) {
#pragma unroll
                            for (int j = 0; j < 4; ++j) { v0[j] = siluf_(v0[j]); v1[j] = siluf_(v1[j]); } }
                        if (act == 2) {
#pragma unroll
                            for (int j = 0; j < 4; ++j) { v0[j] = sigmoidf_(v0[j]); v1[j] = sigmoidf_(v1[j]); } }
                        u32x4 w; w.x = pk2(v0[0], v0[1]); w.y = pk2(v0[2], v0[3]); w.z = pk2(v1[0], v1[1]); w.w = pk2(v1[2], v1[3]);
                        *(u32x4*)(rowp + bj * 128) = w; } }
        }
    }
};
struct EpiGlu {
    bf16_t* segA; const float* bglu;
    __device__ __forceinline__ void operator()(const AccT& acc, const pg8::Unit& u, int wr, int wc, int fr, int fq) const {
        const int row0 = u.pm * 256 + wr * 64 + fr, col0 = u.pn * 256 + wc * 32 + 8 * fq;
        f32x4 bb[2][2];
#pragma unroll
        for (int bj = 0; bj < 2; ++bj) { bb[bj][0] = *(const f32x4*)(bglu + col0 + bj * 128); bb[bj][1] = *(const f32x4*)(bglu + col0 + bj * 128 + 4); }
#pragma unroll
        for (int ai = 0; ai < 2; ++ai) {
            u32x4 yw[4][2], zw[4][2];
#pragma unroll
            for (int m = 0; m < 4; ++m)
#pragma unroll
                for (int bj = 0; bj < 2; ++bj) { const bf16_t* rowp = segA + (size_t)(row0 + ai * 128 + m * 16) * LDA_SEG + col0 + bj * 128; yw[m][bj] = *(const u32x4*)rowp; zw[m][bj] = *(const u32x4*)(rowp + 512); }
#pragma unroll
            for (int m = 0; m < 4; ++m)
#pragma unroll
                for (int bj = 0; bj < 2; ++bj) { bf16_t* rowp = segA + (size_t)(row0 + ai * 128 + m * 16) * LDA_SEG + col0 + bj * 128;
                    float y[8], z[8], o[8]; unpack8(yw[m][bj], y); unpack8(zw[m][bj], z);
#pragma unroll
                    for (int j = 0; j < 4; ++j) { o[j] = y[j] * sigmoidf_(acc[ai][bj][m][0][j] + bb[bj][0][j]) * siluf_(z[j]); o[4 + j] = y[4 + j] * sigmoidf_(acc[ai][bj][m][1][j] + bb[bj][1][j]) * siluf_(z[4 + j]); }
                    *(u32x4*)(rowp + 512) = pack8(o); }
            asm volatile("" ::: "memory"); }
    }
};
template <int MODE> struct EpiMerge {
    bf16_t* dst; const bf16_t* gates; const bf16_t* m5;
    __device__ __forceinline__ void operator()(const AccT& acc, const pg8::Unit& u, int wr, int wc, int fr, int fq) const {
        const int row0 = u.pm * 256 + wr * 64 + fr, col0 = u.pn * 256 + wc * 32 + 8 * fq;
#pragma unroll
        for (int ai = 0; ai < 2; ++ai) {
            u32x4 gw[4][2], mw[4][2];
            if (MODE != 2) {
#pragma unroll
                for (int m = 0; m < 4; ++m)
#pragma unroll
                    for (int bj = 0; bj < 2; ++bj) { const size_t r = (size_t)(row0 + ai * 128 + m * 16); const int c = col0 + bj * 128;
                        gw[m][bj] = *(const u32x4*)(gates + r * 2048 + (MODE == 1 ? 1024 : 0) + c); if (MODE == 1) mw[m][bj] = *(const u32x4*)(m5 + r * 1024 + c); } }
#pragma unroll
            for (int m = 0; m < 4; ++m)
#pragma unroll
                for (int bj = 0; bj < 2; ++bj) { const size_t r = (size_t)(row0 + ai * 128 + m * 16); const int c = col0 + bj * 128;
                    float o[8];
#pragma unroll
                    for (int j = 0; j < 4; ++j) { o[j] = acc[ai][bj][m][0][j]; o[4 + j] = acc[ai][bj][m][1][j]; }
                    if (MODE == 0) { float gt[8]; unpack8(gw[m][bj], gt);
#pragma unroll
                        for (int j = 0; j < 8; ++j) o[j] *= gt[j]; }
                    if (MODE == 1) { float gt[8], mm[8]; unpack8(gw[m][bj], gt); unpack8(mw[m][bj], mm);
#pragma unroll
                        for (int j = 0; j < 8; ++j) o[j] = mm[j] + gt[j] * o[j]; }
                    *(u32x4*)(dst + r * 1024 + c) = pack8(o); }
            asm volatile("" ::: "memory"); }
    }
};
struct EpiOut {
    const float* x; bf16_t* hbf; float* ss;
    __device__ __forceinline__ void operator()(const AccT& acc, const pg8::Unit& u, int wr, int wc, int fr, int fq) const {
        const int row0 = u.pm * 256 + wr * 64 + fr, col0 = u.pn * 256 + wc * 32 + 8 * fq;
#pragma unroll
        for (int ai = 0; ai < 2; ++ai) {
            f32x4 xv[4][2][2];
#pragma unroll
            for (int m = 0; m < 4; ++m)
#pragma unroll
                for (int bj = 0; bj < 2; ++bj) { const float* xp = x + (size_t)(row0 + ai * 128 + m * 16) * 1024 + col0 + bj * 128; xv[m][bj][0] = *(const f32x4*)xp; xv[m][bj][1] = *(const f32x4*)(xp + 4); }
#pragma unroll
            for (int m = 0; m < 4; ++m) { const size_t r = (size_t)(row0 + ai * 128 + m * 16); float s = 0.f;
#pragma unroll
                for (int bj = 0; bj < 2; ++bj) { const int c = col0 + bj * 128;
                    const f32x4 h0 = xv[m][bj][0] + acc[ai][bj][m][0], h1 = xv[m][bj][1] + acc[ai][bj][m][1];
                    u32x4 w; w.x = pk2(h0[0], h0[1]); w.y = pk2(h0[2], h0[3]); w.z = pk2(h1[0], h1[1]); w.w = pk2(h1[2], h1[3]);
                    *(u32x4*)(hbf + r * 1024 + c) = w;
#pragma unroll
                    for (int j = 0; j < 4; ++j) s += h0[j] * h0[j] + h1[j] * h1[j]; }
                s += __shfl_xor(s, 16); s += __shfl_xor(s, 32);
                if (fq == 0) ss[r * 16 + u.pn * 4 + wc] = s; }
            asm volatile("" ::: "memory"); }
    }
};
struct EpiPle {
    const bf16_t* h1bf; bf16_t* h2bf; const bf16_t* plep; const float* ss1; float* ss2;
    __device__ __forceinline__ void operator()(const AccT& acc, const pg8::Unit& u, int wr, int wc, int fr, int fq) const {
        const int row0 = u.pm * 256 + wr * 64 + fr, col0 = u.pn * 256 + wc * 32 + 8 * fq;
#pragma unroll
        for (int ai = 0; ai < 2; ++ai)
#pragma unroll
            for (int mp = 0; mp < 2; ++mp) {
                f32x4 q[2][4]; u32x4 pw[2][2], hw[2][2];
#pragma unroll
                for (int mm = 0; mm < 2; ++mm) { const size_t r = (size_t)(row0 + ai * 128 + (2 * mp + mm) * 16);
#pragma unroll
                    for (int k = 0; k < 4; ++k) q[mm][k] = *(const f32x4*)(ss1 + r * 16 + 4 * k);
#pragma unroll
                    for (int bj = 0; bj < 2; ++bj) { const size_t o = r * 1024 + col0 + bj * 128; pw[mm][bj] = *(const u32x4*)(plep + o); hw[mm][bj] = *(const u32x4*)(h1bf + o); } }
#pragma unroll
                for (int mm = 0; mm < 2; ++mm) { const int m = 2 * mp + mm; const size_t r = (size_t)(row0 + ai * 128 + m * 16); float s = 0.f;
                    const f32x4 qs = (q[mm][0] + q[mm][1]) + (q[mm][2] + q[mm][3]);
                    const float rstd = rsqrtf(((qs[0] + qs[1]) + (qs[2] + qs[3])) * (1.0f / 1024.0f) + 1e-6f);
#pragma unroll
                    for (int bj = 0; bj < 2; ++bj) { const int c = col0 + bj * 128;
                        float pp[8], hh[8]; unpack8(pw[mm][bj], pp); unpack8(hw[mm][bj], hh);
#pragma unroll
                        for (int j = 0; j < 4; ++j) { hh[j] += sigmoidf_(rstd * acc[ai][bj][m][0][j]) * pp[j]; hh[4 + j] += sigmoidf_(rstd * acc[ai][bj][m][1][j]) * pp[4 + j]; }
                        *(u32x4*)(h2bf + r * 1024 + c) = pack8(hh);
#pragma unroll
                        for (int j = 0; j < 8; ++j) s += hh[j] * hh[j]; }
                    s += __shfl_xor(s, 16); s += __shfl_xor(s, 32);
                    if (fq == 0) ss2[r * 16 + u.pn * 4 + wc] = s; }
                asm volatile("" ::: "memory"); }
    }
};

template <int MODE>
__device__ __forceinline__ void xpose_tiles(const float* __restrict__ src, int ldn, int K, bf16_t* __restrict__ dst, int Ndst, const float* __restrict__ kscale, LAS float* tile, int wg, int nwg) {
    const int nkt = K / 64, ntile = nkt * (Ndst / 64);
    for (int t = wg; t < ntile; t += nwg) {
        const int n0 = (t / nkt) * 64, k0 = (t % nkt) * 64;
        { const int r = threadIdx.x >> 4, c4 = (threadIdx.x & 15) * 4;
#pragma unroll
          for (int i = 0; i < 2; ++i) { const int k = k0 + r + 32 * i, n = n0 + c4; int sc = n;
              if (MODE == 1) sc = n < 5120 ? n : n + 24;
              if (MODE == 2) sc = n < 24 ? 5120 + n : -1;
              f32x4 v = (f32x4){0.f, 0.f, 0.f, 0.f};
              if (sc >= 0) v = *(const f32x4*)(src + (size_t)k * ldn + sc);
              if (kscale) v *= kscale[k];
              LAS float* tp = tile + (r + 32 * i) * 65 + c4; tp[0] = v[0]; tp[1] = v[1]; tp[2] = v[2]; tp[3] = v[3]; } }
        __syncthreads();
        { const int n = threadIdx.x >> 3, k8 = (threadIdx.x & 7) * 8; float f[8];
#pragma unroll
          for (int j = 0; j < 8; ++j) f[j] = tile[(k8 + j) * 65 + n];
          *(u32x4*)(dst + (size_t)(n0 + n) * K + k0 + k8) = pack8(f); }
        __syncthreads();
    }
}

__device__ __forceinline__ void dsincos(double x, double& s, double& c) {
    const double twopi = 6.283185307179586476925, hp = 1.5707963267948966192;
    x -= rint(x / twopi) * twopi;
    const double q = rint(x / hp); const double r = x - q * hp; const int qi = ((int)q) & 3;
    const double r2 = r * r;
    double sn = r * (1.0 + r2 * (-1.0 / 6 + r2 * (1.0 / 120 + r2 * (-1.0 / 5040 + r2 * (1.0 / 362880 + r2 * (-1.0 / 39916800 + r2 * (1.0 / 6227020800.0)))))));
    double cs = 1.0 + r2 * (-0.5 + r2 * (1.0 / 24 + r2 * (-1.0 / 720 + r2 * (1.0 / 40320 + r2 * (-1.0 / 3628800 + r2 * (1.0 / 479001600.0 + r2 * (-1.0 / 87178291200.0)))))));
    if (qi == 0) { s = sn; c = cs; } else if (qi == 1) { s = cs; c = -sn; } else if (qi == 2) { s = -sn; c = -cs; } else { s = -cs; c = sn; }
}
__device__ __forceinline__ void phase0(const Params& p, LAS unsigned char* lds) {
    const int tid = threadIdx.x, lane = tid & 63, gw = blockIdx.x * 8 + (tid >> 6), nw = gridDim.x * 8;
    bf16_t* xn = (bf16_t*)(p.ws + OFF_XN);
    for (int row0 = gw * 4; row0 < T_TOK; row0 += nw * 4) {
        f32x4 v[4][4]; float ss[4];
#pragma unroll
        for (int rr = 0; rr < 4; ++rr) { const f32x4* xr = (const f32x4*)(p.x + (size_t)(row0 + rr) * DM);
#pragma unroll
            for (int i = 0; i < 4; ++i) v[rr][i] = xr[lane + 64 * i]; }
#pragma unroll
        for (int rr = 0; rr < 4; ++rr) { float a = 0.f;
#pragma unroll
            for (int i = 0; i < 4; ++i) a += (v[rr][i][0] * v[rr][i][0] + v[rr][i][1] * v[rr][i][1]) + (v[rr][i][2] * v[rr][i][2] + v[rr][i][3] * v[rr][i][3]);
            ss[rr] = rsqrtf(wave_sum(a) * (1.0f / 1024.0f) + 1e-6f); }
#pragma unroll
        for (int i = 0; i < 4; ++i) { const f32x4 w = ((const f32x4*)p.norm_w)[lane + 64 * i];
#pragma unroll
            for (int rr = 0; rr < 4; ++rr) { const float r = ss[rr]; u32x2 o; o.x = pk2(v[rr][i][0] * r * w[0], v[rr][i][1] * r * w[1]); o.y = pk2(v[rr][i][2] * r * w[2], v[rr][i][3] * r * w[3]);
                *(u32x2*)(xn + (size_t)(row0 + rr) * DM + 4 * (lane + 64 * i)) = o; } }
    }
    xpose_tiles<1>(p.w_in, 7192, 1024, (bf16_t*)(p.ws + OFF_WIN), N_INP, nullptr, (LAS float*)lds, blockIdx.x, gridDim.x);
    xpose_tiles<2>(p.w_in, 7192, 1024, (bf16_t*)(p.ws + OFF_WDT), 64, nullptr, (LAS float*)lds, blockIdx.x, gridDim.x);
    xpose_tiles<0>(p.wglu, 512, 512, (bf16_t*)(p.ws + OFF_WGLU), 512, nullptr, (LAS float*)lds, blockIdx.x, gridDim.x);
    for (int gt = gw; gt < 2048; gt += nw) {
        const int g = gt >> 6, pp = gt & 63;
        const double step = exp((double)p.logstep[g]), ar = p.a_re[gt], ai = p.a_im[gt];
        const double mag = exp(ar * step); double sn, cs; dsincos(ai * step, sn, cs);
        const double lr = mag * cs, li = mag * sn, den = ar * ar + ai * ai, nr = lr - 1.0, ni = li;
        const double fre = (nr * ar + ni * ai) / den, fim = (ni * ar - nr * ai) / den;
        double pr = lr, pi = li;
#pragma unroll
        for (int i = 0; i < 7; ++i) { const double t = pr * pr - pi * pi; pi = 2.0 * pr * pi; pr = t; }
        if (lane == 0) { float* lam = (float*)(p.ws + OFF_LAM); float* lamL = (float*)(p.ws + OFF_LAML);
            lam[gt * 2] = (float)lr; lam[gt * 2 + 1] = (float)li; lamL[gt * 2] = (float)pr; lamL[gt * 2 + 1] = (float)pi; }
        bf16_t* bbt = (bf16_t*)(p.ws + OFF_BBT) + (size_t)g * 128 * 32; bf16_t* cwt = (bf16_t*)(p.ws + OFF_CWT) + (size_t)g * 16 * 128;
        if (lane < 16) { const int h = lane;
            const double br = p.b_re[gt * 16 + h], bi = p.b_im[gt * 16 + h];
            bbt[pp * 32 + h] = (bf16_t)(pk2((float)(fre * br - fim * bi), 0.f) & 0xffffu);
            bbt[(64 + pp) * 32 + h] = (bf16_t)(pk2((float)(fre * bi + fim * br), 0.f) & 0xffffu);
            cwt[h * 128 + pp] = (bf16_t)(pk2(p.c_re[(g * 16 + h) * 64 + pp], 0.f) & 0xffffu);
            cwt[h * 128 + 64 + pp] = (bf16_t)(pk2(-p.c_im[(g * 16 + h) * 64 + pp], 0.f) & 0xffffu);
        } else if (lane < 32) { bbt[pp * 32 + lane] = 0; bbt[(64 + pp) * 32 + lane] = 0; }
    }
}

template <int NCH> struct ConvMap { static constexpr int NOCT = NCH / 8, RUNS = 512 / NOCT, RL = 128 / RUNS; };
__device__ __forceinline__ void conv_load(const Params& p, int b, int c, int ch0, u32x4 (&raw)[7]) {
    const int co = threadIdx.x & 15, t0 = (threadIdx.x >> 4) * 4, ch = ch0 + co * 8;
    const bf16_t* segB = (const bf16_t*)(p.ws + OFF_SEGB);
#pragma unroll
    for (int i = 0; i < 7; ++i) { const int l = c * CH + t0 - 3 + i;
        raw[i] = (u32x4){0u, 0u, 0u, 0u};
        if (l >= 0) raw[i] = *(const u32x4*)(segB + (size_t)(b * SEQ + l) * LDA_SEG + ch); }
}
constexpr int CW_OFF = 112640;
__device__ __forceinline__ void conv_fill(const Params& p, LAS unsigned char* lds, int g) {
    LAS float* cw = (LAS float*)(lds + CW_OFF);
    for (int idx = threadIdx.x; idx < 5 * 5 * 128; idx += 512) { const int tile = idx / 640, k = (idx % 640) >> 7, ch = idx & 127;
        const int cb = tile < 3 ? (g * 6 + 2 * tile) * 64 : (tile == 3 ? 1536 + g * 128 : 2048 + g * 128);
        cw[idx] = k < 4 ? p.convw[k * 2560 + cb + ch] : p.convb[cb + ch]; }
    __syncthreads();
}
__device__ __forceinline__ void conv_compute(const LAS float* cwt  , const u32x4 (&raw)[7], float (&o)[4][8], int& t0, int& co) {
    co = threadIdx.x & 15; t0 = (threadIdx.x >> 4) * 4;
    float xr[7][8];
#pragma unroll
    for (int i = 0; i < 7; ++i) unpack8(raw[i], xr[i]);
    float cb[8];
    { const f32x4 b0 = *(const LAS f32x4*)(cwt + 4 * 128 + co * 8), b1 = *(const LAS f32x4*)(cwt + 4 * 128 + co * 8 + 4);
#pragma unroll
      for (int j = 0; j < 4; ++j) { cb[j] = b0[j]; cb[4 + j] = b1[j]; } }
#pragma unroll
    for (int i = 0; i < 4; ++i)
#pragma unroll
        for (int e = 0; e < 8; ++e) o[i][e] = cb[e];
#pragma unroll
    for (int k = 0; k < 4; ++k) { const f32x4 w0 = *(const LAS f32x4*)(cwt + k * 128 + co * 8), w1 = *(const LAS f32x4*)(cwt + k * 128 + co * 8 + 4);
#pragma unroll
        for (int i = 0; i < 4; ++i) {
#pragma unroll
            for (int j = 0; j < 4; ++j) { o[i][j] += w0[j] * xr[i + k][j]; o[i][4 + j] += w1[j] * xr[i + k][4 + j]; } } }
#pragma unroll
    for (int i = 0; i < 4; ++i)
#pragma unroll
        for (int e = 0; e < 8; ++e) o[i][e] = siluf_(o[i][e]);
}

constexpr int LP = 136;
__device__ __forceinline__ int tsw_w(int row, int t0) { return row * LP + ((((t0 >> 3) ^ (row >> 3)) & 15) << 3) + (t0 & 7); }
__device__ __forceinline__ int tsw_r(int row, int kb) { return row * LP + (((kb ^ (row >> 3)) & 15) << 3); }
__device__ __forceinline__ void ssd_acum(const Params& p, int b, int c, int g, LAS float* acum, LAS float* dts) {
    const int wid = threadIdx.x >> 6, lane = threadIdx.x & 63;
    if (wid < 6) {
        const int h = g * 6 + wid; const float A = -__expf(p.alog[h]);
        const float* dtv = (const float*)(p.ws + OFF_DTV) + (size_t)(b * SEQ + c * CH) * 24 + h;
        const float v0 = dtv[(2 * lane) * 24], v1 = dtv[(2 * lane + 1) * 24];
        const float d0 = v0 * A, d1 = v1 * A; float s = d0 + d1, inc = s;
#pragma unroll
        for (int o = 1; o < 64; o <<= 1) { const float t = __shfl_up(inc, o); if (lane >= o) inc += t; }
        const float ex = inc - s;
        acum[wid * 128 + 2 * lane] = ex + d0; acum[wid * 128 + 2 * lane + 1] = ex + d0 + d1;
        dts[wid * 128 + 2 * lane] = v0; dts[wid * 128 + 2 * lane + 1] = v1;
    }
}

__device__ __forceinline__ void ssd_states_item(const Params& p, LAS unsigned char* lds, int item) {
    const int g = item & 3, c = (item >> 2) & 15, b = item >> 6;
    const int tid = threadIdx.x, wid = tid >> 6, lane = tid & 63, fr = lane & 15, fq = lane >> 4;
    LAS bf16_t* BsT = (LAS bf16_t*)lds;
    LAS bf16_t* XdT = (LAS bf16_t*)(lds + 34816);
    LAS float* acum = (LAS float*)(lds + 69632);
    LAS float* dts = (LAS float*)(lds + 72704);
    u32x4 rawA[7], rawB[7];
    conv_load(p, b, c, 1536 + g * 128, rawA);
    conv_load(p, b, c, (g * 6) * 64, rawB);
    ssd_acum(p, b, c, g, acum, dts);
    { float o[4][8]; int t0, co; conv_compute((const LAS float*)(lds + CW_OFF) + 3 * 640, rawA, o, t0, co);
#pragma unroll
      for (int e = 0; e < 8; ++e) { u32x2 w; w.x = pk2(o[0][e], o[1][e]); w.y = pk2(o[2][e], o[3][e]); *(LAS u32x2*)(BsT + tsw_w(co * 8 + e, t0)) = w; } }
    __syncthreads();
    bf16_t* states = (bf16_t*)(p.ws + OFF_STATES);
#pragma unroll 1
    for (int hp = 0; hp < 3; ++hp) {
        { float o[4][8]; int t0, co; conv_compute((const LAS float*)(lds + CW_OFF) + hp * 640, rawB, o, t0, co);
          if (hp < 2) conv_load(p, b, c, (g * 6 + 2 * hp + 2) * 64, rawB);
          const int hl = 2 * hp + (co >> 3); const float alast = acum[hl * 128 + 127]; float sc[4];
#pragma unroll
          for (int i = 0; i < 4; ++i) sc[i] = dts[hl * 128 + t0 + i] * __expf(alast - acum[hl * 128 + t0 + i]);
#pragma unroll
          for (int e = 0; e < 8; ++e) { u32x2 w; w.x = pk2(o[0][e] * sc[0], o[1][e] * sc[1]); w.y = pk2(o[2][e] * sc[2], o[3][e] * sc[3]); *(LAS u32x2*)(XdT + tsw_w(co * 8 + e, t0)) = w; } }
        __syncthreads();
        f32x4 acc[8];
#pragma unroll
        for (int n = 0; n < 8; ++n) acc[n] = (f32x4){0.f, 0.f, 0.f, 0.f};
#pragma unroll
        for (int kk = 0; kk < 4; ++kk) { const bf16x8 xf = *(const LAS bf16x8*)(XdT + tsw_r(wid * 16 + fr, kk * 4 + fq));
#pragma unroll
            for (int n = 0; n < 8; ++n) { const bf16x8 bf = *(const LAS bf16x8*)(BsT + tsw_r(n * 16 + fr, kk * 4 + fq)); acc[n] = __builtin_amdgcn_mfma_f32_16x16x32_bf16(bf, xf, acc[n], 0, 0, 0); } }
        const int h = g * 6 + 2 * hp + (wid >> 2), prow = (wid & 3) * 16 + fr;
        bf16_t* dst = states + ((size_t)((b * NCHUNK + c) * 24 + h) * 64 + prow) * 128 + 4 * fq;
#pragma unroll
        for (int n = 0; n < 8; ++n) { u32x2 w; w.x = pk2(acc[n][0], acc[n][1]); w.y = pk2(acc[n][2], acc[n][3]); *(u32x2*)(dst + n * 16) = w; }
        __syncthreads();
    }
    if (tid < 6) ((float*)(p.ws + OFF_CDEC))[(b * NCHUNK + c) * 24 + g * 6 + tid] = __expf(acum[tid * 128 + 127]);
    __syncthreads();
}

__device__ __forceinline__ void ssd_prefix(const Params& p) {
    bf16_t* states = (bf16_t*)(p.ws + OFF_STATES); const float* cdec = (const float*)(p.ws + OFF_CDEC);
    const int nthr = gridDim.x * 512;
    for (int v = blockIdx.x * 512 + threadIdx.x; v < NBATCH * 24 * 1024; v += nthr) {
        const int bh = v >> 10, e = v & 1023, b = bh / 24, h = bh % 24;
        u32x4 s[NCHUNK];
#pragma unroll
        for (int c = 0; c < NCHUNK; ++c) s[c] = *(const u32x4*)(states + (size_t)((b * NCHUNK + c) * 24 + h) * 8192 + e * 8);
        float prev[8];
#pragma unroll
        for (int j = 0; j < 8; ++j) prev[j] = 0.f;
#pragma unroll
        for (int c = 0; c < NCHUNK; ++c) {
            *(u32x4*)(states + (size_t)((b * NCHUNK + c) * 24 + h) * 8192 + e * 8) = pack8(prev);
            const float d = cdec[(b * NCHUNK + c) * 24 + h]; float f[8]; unpack8(s[c], f);
#pragma unroll
            for (int j = 0; j < 8; ++j) prev[j] = prev[j] * d + f[j];
        }
    }
}

__device__ __forceinline__ void ssd_out_item(const Params& p, LAS unsigned char* lds, int item) {
    const int g = item & 3, c = (item >> 2) & 15, b = item >> 6;
    const int tid = threadIdx.x, wid = tid >> 6, lane = tid & 63, fr = lane & 15, fq = lane >> 4;
    LAS bf16_t* Cs = (LAS bf16_t*)lds;
    LAS bf16_t* Bs = (LAS bf16_t*)(lds + 34816);
    LAS bf16_t* XT = (LAS bf16_t*)(lds + 69632);
    LAS float* acum = (LAS float*)(lds + 104448);
    LAS float* dts = (LAS float*)(lds + 107520);
    LAS float* red = (LAS float*)(lds + 110592);
    const size_t tok0 = (size_t)b * SEQ + c * CH;
    u32x4 rawA[7], rawB[7];
    conv_load(p, b, c, 2048 + g * 128, rawA);
    conv_load(p, b, c, 1536 + g * 128, rawB);
    ssd_acum(p, b, c, g, acum, dts);
    { float o[4][8]; int t0, co; conv_compute((const LAS float*)(lds + CW_OFF) + 4 * 640, rawA, o, t0, co);
#pragma unroll
      for (int i = 0; i < 4; ++i) *(LAS u32x4*)(Cs + (t0 + i) * LP + co * 8) = pack8(o[i]); }
    conv_load(p, b, c, (g * 6) * 64, rawA);
    { float o[4][8]; int t0, co; conv_compute((const LAS float*)(lds + CW_OFF) + 3 * 640, rawB, o, t0, co);
#pragma unroll
      for (int i = 0; i < 4; ++i) *(LAS u32x4*)(Bs + (t0 + i) * LP + co * 8) = pack8(o[i]); }
    __syncthreads();
    LAS float* vtab = (LAS float*)(lds + 125440);
    for (int idx = tid; idx < 6 * 128; idx += 512) vtab[idx] = __expf(acum[idx | 15] - acum[idx]) * dts[idx];
    f32x4 S[8];
#pragma unroll
    for (int st = 0; st < 8; ++st) S[st] = (f32x4){0.f, 0.f, 0.f, 0.f};
#pragma unroll
    for (int kk = 0; kk < 4; ++kk) { const bf16x8 cf = *(const LAS bf16x8*)(Cs + (wid * 16 + fr) * LP + kk * 32 + fq * 8);
#pragma unroll
        for (int st = 0; st < 8; ++st) if (st <= wid) { const bf16x8 bf = *(const LAS bf16x8*)(Bs + (st * 16 + fr) * LP + kk * 32 + fq * 8); S[st] = __builtin_amdgcn_mfma_f32_16x16x32_bf16(bf, cf, S[st], 0, 0, 0); } }
    __syncthreads();
    LAS bf16_t* Pb = Bs;
    const int half = wid >> 2, pt = wid & 3;
    float ssq[4] = {0.f, 0.f, 0.f, 0.f};
    const bf16_t* states = (const bf16_t*)(p.ws + OFF_STATES);
    bf16_t* segA = (bf16_t*)(p.ws + OFF_SEGA);
    bf16x8 pfn[4];
    { const bf16_t* pr = states + ((size_t)((b * NCHUNK + c) * 24 + g * 6) * 64 + pt * 16 + fr) * 128 + fq * 8;
#pragma unroll
      for (int kk = 0; kk < 4; ++kk) pfn[kk] = *(const bf16x8*)(pr + kk * 32);
 }
#pragma unroll 1
    for (int j = 0; j < 6; ++j) {
        const int hp = j >> 1, hs = j & 1, h = g * 6 + j;
        if (hs == 0) { float o[4][8]; int t0, co; conv_compute((const LAS float*)(lds + CW_OFF) + hp * 640, rawA, o, t0, co);
          if (hp < 2) conv_load(p, b, c, (g * 6 + 2 * hp + 2) * 64, rawA);
#pragma unroll
          for (int e = 0; e < 8; ++e) { u32x2 w; w.x = pk2(o[0][e], o[1][e]); w.y = pk2(o[2][e], o[3][e]); *(LAS u32x2*)(XT + tsw_w(co * 8 + e, t0)) = w; } }
        {
            bf16x8 pf[4]; u32x2 zw4[4];
#pragma unroll
            for (int kk = 0; kk < 4; ++kk) pf[kk] = pfn[kk];
#pragma unroll
            for (int q = 0; q < 4; ++q) { const int lt = half == 0 ? (q == 0 ? 0 : (q == 1 ? 3 : (q == 2 ? 4 : 7))) : (q == 0 ? 1 : (q == 1 ? 2 : (q == 2 ? 5 : 6)));
                zw4[q] = *(const u32x2*)(segA + (tok0 + lt * 16 + fr) * LDA_SEG + 1024 + h * 64 + pt * 16 + 4 * fq); }
            if (j < 5) { const bf16_t* pr = states + ((size_t)((b * NCHUNK + c) * 24 + h + 1) * 64 + pt * 16 + fr) * 128 + fq * 8;
#pragma unroll
              for (int kk = 0; kk < 4; ++kk) pfn[kk] = *(const bf16x8*)(pr + kk * 32); }
            {
              const int l = wid * 16 + fr; const float al = acum[j * 128 + l], Dh = p.ssdd[h];
#pragma unroll
              for (int st = 0; st < 8; ++st) if (st <= (wid | 1)) { float v[4];
                  if (st < wid) {
                      const float uu = __expf(al - acum[j * 128 + st * 16 + 15]); const f32x4 v4 = *(const LAS f32x4*)(vtab + j * 128 + st * 16 + 4 * fq);
#pragma unroll
                      for (int jj = 0; jj < 4; ++jj) v[jj] = S[st][jj] * uu * v4[jj];
                  } else {
                      const f32x4 as4 = *(const LAS f32x4*)(acum + j * 128 + st * 16 + 4 * fq), ds4 = *(const LAS f32x4*)(dts + j * 128 + st * 16 + 4 * fq);
#pragma unroll
                      for (int jj = 0; jj < 4; ++jj) { const int sx = st * 16 + 4 * fq + jj; float t = 0.f;
                          if (sx <= l) t = S[st][jj] * __expf(al - as4[jj]) * ds4[jj];
                          if (sx == l) t += Dh; v[jj] = t; } }
                  u32x2 w; w.x = pk2(v[0], v[1]); w.y = pk2(v[2], v[3]); *(LAS u32x2*)(Pb + l * LP + st * 16 + 4 * fq) = w; } }
            __syncthreads();
            bf16x8 xf[4];
#pragma unroll
            for (int kk = 0; kk < 4; ++kk) xf[kk] = *(const LAS bf16x8*)(XT + tsw_r(hs * 64 + pt * 16 + fr, kk * 4 + fq));
            __builtin_amdgcn_s_setprio(1);
#pragma unroll
            for (int q = 0; q < 4; ++q) {
                const int lt = half == 0 ? (q == 0 ? 0 : (q == 1 ? 3 : (q == 2 ? 4 : 7))) : (q == 0 ? 1 : (q == 1 ? 2 : (q == 2 ? 5 : 6)));
                f32x4 ad = (f32x4){0.f, 0.f, 0.f, 0.f}, ao = (f32x4){0.f, 0.f, 0.f, 0.f};
#pragma unroll
                for (int kk = 0; kk < 4; ++kk) if (kk <= (lt >> 1)) { const bf16x8 pfr = *(const LAS bf16x8*)(Pb + (lt * 16 + fr) * LP + kk * 32 + fq * 8); ad = __builtin_amdgcn_mfma_f32_16x16x32_bf16(xf[kk], pfr, ad, 0, 0, 0); }
#pragma unroll
                for (int kk = 0; kk < 4; ++kk) { const bf16x8 cfr = *(const LAS bf16x8*)(Cs + (lt * 16 + fr) * LP + kk * 32 + fq * 8); ao = __builtin_amdgcn_mfma_f32_16x16x32_bf16(pf[kk], cfr, ao, 0, 0, 0); }
                const int l = lt * 16 + fr; const float ea = __expf(acum[j * 128 + l]);
                bf16_t* zp = segA + (tok0 + l) * LDA_SEG + 1024 + h * 64 + pt * 16 + 4 * fq;
                const u32x2 zw = zw4[q];
                const float y0 = (ad[0] + ea * ao[0]) * siluf_(bflo(zw.x)), y1 = (ad[1] + ea * ao[1]) * siluf_(bfhi(zw.x)), y2 = (ad[2] + ea * ao[2]) * siluf_(bflo(zw.y)), y3 = (ad[3] + ea * ao[3]) * siluf_(bfhi(zw.y));
                ssq[q] += (y0 * y0 + y1 * y1) + (y2 * y2 + y3 * y3);
                u32x2 yo; yo.x = pk2(y0, y1); yo.y = pk2(y2, y3); if (!(p.dry & 1)) *(u32x2*)zp = yo;
            }
            __builtin_amdgcn_s_setprio(0);
            __syncthreads();
        }
    }
#pragma unroll
    for (int q = 0; q < 4; ++q) { float s = ssq[q]; s += __shfl_xor(s, 16); s += __shfl_xor(s, 32); if (fq == 0) red[wid * 64 + q * 16 + fr] = s; }
    __syncthreads();
    float rstd[4];
#pragma unroll
    for (int q = 0; q < 4; ++q) { const int o = q * 16 + fr; const float tot = (red[(half * 4 + 0) * 64 + o] + red[(half * 4 + 1) * 64 + o]) + (red[(half * 4 + 2) * 64 + o] + red[(half * 4 + 3) * 64 + o]);
        rstd[q] = rsqrtf(tot * (1.0f / 384.0f) + 1e-6f); }
#pragma unroll
    for (int j = 0; j < 6; ++j) { const int h = g * 6 + j; const f32x4 nw = *(const f32x4*)(p.ssdnw + h * 64 + pt * 16 + 4 * fq);
#pragma unroll
        for (int q = 0; q < 4; ++q) {
            const int lt = half == 0 ? (q == 0 ? 0 : (q == 1 ? 3 : (q == 2 ? 4 : 7))) : (q == 0 ? 1 : (q == 1 ? 2 : (q == 2 ? 5 : 6)));
            const int l = lt * 16 + fr; bf16_t* zp = segA + (tok0 + l) * LDA_SEG + 1024 + h * 64 + pt * 16 + 4 * fq;
            const u32x2 w = *(const u32x2*)zp; u32x2 o;
            o.x = pk2(bflo(w.x) * rstd[q] * nw[0], bfhi(w.x) * rstd[q] * nw[1]); o.y = pk2(bflo(w.y) * rstd[q] * nw[2], bfhi(w.y) * rstd[q] * nw[3]);
            if (!(p.dry & 1)) *(u32x2*)zp = o; } }
    __syncthreads();
}

template <int PASS>
__device__ __forceinline__ void s5_wave_item(const Params& p, LAS float* wl  , int item) {
    const int g = item & 31, c = (item >> 5) & 15, b = item >> 9;
    const int lane = threadIdx.x & 63, fr = lane & 15, fq = lane >> 4;
    const size_t tok0 = (size_t)b * SEQ + c * CH;
    bf16_t* segA = (bf16_t*)(p.ws + OFF_SEGA);
    const float* lam = (const float*)(p.ws + OFF_LAM); const float lr = lam[(g * 64 + lane) * 2], li = lam[(g * 64 + lane) * 2 + 1];
    float* E = (float*)(p.ws + OFF_E);
    bf16x8 bbf[8];
    { const bf16_t* bbt = (const bf16_t*)(p.ws + OFF_BBT) + (size_t)g * 128 * 32;
#pragma unroll
      for (int n = 0; n < 8; ++n) bbf[n] = *(const bf16x8*)(bbt + (n * 16 + fr) * 32 + fq * 8); }
    float sr = 0.f, si = 0.f;
    bf16x8 cwf[4]; f32x4 dv = (f32x4){0.f, 0.f, 0.f, 0.f};
    if (PASS == 2) {
        const float* lamL = (const float*)(p.ws + OFF_LAML); const float Lr = lamL[(g * 64 + lane) * 2], Li = lamL[(g * 64 + lane) * 2 + 1];
        float er[15], ei[15];
#pragma unroll
        for (int cc = 0; cc < 15; ++cc) { er[cc] = 0.f; ei[cc] = 0.f; if (cc < c) { er[cc] = E[(size_t)((b * NCHUNK + cc) * 32 + g) * 128 + lane]; ei[cc] = E[(size_t)((b * NCHUNK + cc) * 32 + g) * 128 + 64 + lane]; } }
#pragma unroll
        for (int cc = 0; cc < 15; ++cc) if (cc < c) { const float nr = Lr * sr - Li * si + er[cc], ni = Lr * si + Li * sr + ei[cc]; sr = nr; si = ni; }
        const bf16_t* cwt = (const bf16_t*)(p.ws + OFF_CWT) + (size_t)g * 16 * 128;
#pragma unroll
        for (int kk = 0; kk < 4; ++kk) cwf[kk] = *(const bf16x8*)(cwt + fr * 128 + kk * 32 + fq * 8);
        dv = *(const f32x4*)(p.s5d + g * 16 + 4 * fq);
    }
    bf16x8 ufa[8]; u32x2 uwa[8];
#pragma unroll
    for (int bt = 0; bt < 8; ++bt) { ufa[bt] = (bf16x8){0, 0, 0, 0, 0, 0, 0, 0}; uwa[bt] = (u32x2){0u, 0u};
        if (fq < 2) ufa[bt] = *(const bf16x8*)(segA + (tok0 + bt * 16 + fr) * LDA_SEG + g * 16 + fq * 8);
        if (PASS == 2) uwa[bt] = *(const u32x2*)(segA + (tok0 + bt * 16 + fr) * LDA_SEG + g * 16 + 4 * fq); }
#pragma unroll
    for (int bt = 0; bt < 8; ++bt) {
        const size_t trow = tok0 + bt * 16 + fr;
        const bf16x8 uf = ufa[bt]; const u32x2 uw = uwa[bt];
        f32x4 bu[8];
#pragma unroll
        for (int n = 0; n < 8; ++n) { bu[n] = (f32x4){0.f, 0.f, 0.f, 0.f}; bu[n] = __builtin_amdgcn_mfma_f32_16x16x32_bf16(bbf[n], uf, bu[n], 0, 0, 0); }
        asm volatile("s_nop 15\n\ts_nop 15" : "+v"(bu[0]), "+v"(bu[1]), "+v"(bu[2]), "+v"(bu[3]), "+v"(bu[4]), "+v"(bu[5]), "+v"(bu[6]), "+v"(bu[7]));
#pragma unroll
        for (int n = 0; n < 8; ++n) *(LAS f32x4*)(wl + fr * 132 + n * 16 + 4 * fq) = bu[n];
        asm volatile("s_waitcnt lgkmcnt(0)" ::: "memory"); __builtin_amdgcn_wave_barrier();
        float br[16], bi[16];
#pragma unroll
        for (int t = 0; t < 16; ++t) { br[t] = wl[t * 132 + lane]; bi[t] = wl[t * 132 + 64 + lane]; }
#pragma unroll
        for (int t = 0; t < 16; ++t) { const float nr = lr * sr - li * si + br[t], ni = lr * si + li * sr + bi[t]; sr = nr; si = ni; br[t] = sr; bi[t] = si; }
        if (PASS == 2) {
#pragma unroll
            for (int t = 0; t < 16; ++t) { wl[t * 132 + lane] = br[t]; wl[t * 132 + 64 + lane] = bi[t]; } }
        if (PASS == 2) {
            asm volatile("s_waitcnt lgkmcnt(0)" ::: "memory"); __builtin_amdgcn_wave_barrier();
            f32x4 a = (f32x4){0.f, 0.f, 0.f, 0.f};
#pragma unroll
            for (int kk = 0; kk < 4; ++kk) { const f32x4 s0 = *(const LAS f32x4*)(wl + fr * 132 + kk * 32 + fq * 8), s1 = *(const LAS f32x4*)(wl + fr * 132 + kk * 32 + fq * 8 + 4);
                u32x4 w; w.x = pk2(s0[0], s0[1]); w.y = pk2(s0[2], s0[3]); w.z = pk2(s1[0], s1[1]); w.w = pk2(s1[2], s1[3]);
                bf16x8 sf; __builtin_memcpy(&sf, &w, 16);
                a = __builtin_amdgcn_mfma_f32_16x16x32_bf16(cwf[kk], sf, a, 0, 0, 0); }
            bf16_t* up = segA + trow * LDA_SEG + g * 16 + 4 * fq;
            const float y0 = geluf_(a[0] + dv[0] * bflo(uw.x)), y1 = geluf_(a[1] + dv[1] * bfhi(uw.x)), y2 = geluf_(a[2] + dv[2] * bflo(uw.y)), y3 = geluf_(a[3] + dv[3] * bfhi(uw.y));
            u32x2 o; o.x = pk2(y0, y1); o.y = pk2(y2, y3); if (!(p.dry & 2)) *(u32x2*)up = o;
            asm volatile("s_waitcnt lgkmcnt(0)" ::: "memory"); __builtin_amdgcn_wave_barrier();
        }
    }
    if (PASS == 1) { E[(size_t)((b * NCHUNK + c) * 32 + g) * 128 + lane] = sr; E[(size_t)((b * NCHUNK + c) * 32 + g) * 128 + 64 + lane] = si; }
}

#define XB_TMO      128
#define XB_XCNT(j)  (256  + 64 * (j))
#define XB_XSUB(j)  (1280 + 64 * (j))
#define XB_XGEN(j)  (2304 + 64 * (j))
#define XB_TOP      3328
#define XB_TOPGEN   3392
#define XCD_BAR_WORDS 3456
#define XB_SPIN_CAP (1u << 18)
__device__ __forceinline__ unsigned xb_ld(unsigned* p)              { return __hip_atomic_load(p, __ATOMIC_RELAXED, __HIP_MEMORY_SCOPE_AGENT); }
__device__ __forceinline__ unsigned xb_add(unsigned* p, unsigned v) { return __hip_atomic_fetch_add(p, v, __ATOMIC_RELAXED, __HIP_MEMORY_SCOPE_AGENT); }
__device__ __forceinline__ unsigned xb_xcc_id() { return (unsigned)__builtin_amdgcn_s_getreg((3 << 11) | 20) & 0xFu; }
#define XB_SPIN(cond, bar) do { unsigned _sp = 0; while (cond) { __builtin_amdgcn_s_sleep(1); \
    if ((++_sp & 255u) == 0u) { if (xb_ld(&(bar)[XB_TMO])) break; if (_sp > XB_SPIN_CAP) { atomicAdd(&(bar)[XB_TMO], 1u); break; } } } } while (0)
struct XcdBarrier { unsigned* bar; unsigned x; volatile LAS unsigned* st; };
__device__ __forceinline__ XcdBarrier xcd_barrier_post(unsigned* bar, volatile LAS unsigned* st) {
    XcdBarrier b; b.bar = bar; b.x = xb_xcc_id(); b.st = st;
    if (threadIdx.x == 0) (void)xb_add(&bar[XB_XCNT(b.x)], 1u);
    return b;
}
__device__ __forceinline__ void xcd_barrier_complete(unsigned* bar, unsigned x, unsigned& nloc, unsigned& nx) {
    const unsigned G = gridDim.x * gridDim.y * gridDim.z;
    unsigned sum, cnt, mine, sp = 0u;
    for (;;) {
        sum = 0u; cnt = 0u; mine = 0u;
#pragma unroll
        for (unsigned j = 0; j < 16; ++j) { const unsigned c = xb_ld(&bar[XB_XCNT(j)]); sum += c; cnt += (c > 0u) ? 1u : 0u; mine = (j == x) ? c : mine; }
        if (sum == G) break;
        __builtin_amdgcn_s_sleep(1);
        if ((++sp & 255u) == 0u) { if (xb_ld(&bar[XB_TMO])) break; if (sp > XB_SPIN_CAP) { atomicAdd(&bar[XB_TMO], 1u); break; } }
    }
    nloc = mine > 0u ? mine : 1u; nx = cnt > 0u ? cnt : 1u;
}
__device__ __forceinline__ void xcd_barrier(const XcdBarrier& b) {
    asm volatile("s_waitcnt vmcnt(0)" ::: "memory");
    __syncthreads();
    if (threadIdx.x == 0) {
        unsigned* bar = b.bar;
        __builtin_amdgcn_s_waitcnt(0);
        unsigned nloc = b.st[0], nx = b.st[1];
        if (nloc == 0u) { xcd_barrier_complete(bar, b.x, nloc, nx); b.st[0] = nloc; b.st[1] = nx; }
        const unsigned old = xb_add(&bar[XB_XSUB(b.x)], 1u);
        const unsigned gen = old / nloc;
        if (old + 1u == (gen + 1u) * nloc) {
            __builtin_amdgcn_fence(__ATOMIC_RELEASE, "agent");
            asm volatile("s_waitcnt vmcnt(0)" ::: "memory");
            const unsigned og = xb_add(&bar[XB_TOP], 1u);
            const unsigned tg = og / nx;
            if (og + 1u == (tg + 1u) * nx) xb_add(&bar[XB_TOPGEN], 1u);
            else XB_SPIN(xb_ld(&bar[XB_TOPGEN]) == tg, bar);
            __builtin_amdgcn_fence(__ATOMIC_ACQUIRE, "agent");
            xb_add(&bar[XB_XGEN(b.x)], 1u);
            asm volatile("s_waitcnt vmcnt(0)" ::: "memory");
        } else {
            XB_SPIN(xb_ld(&bar[XB_XGEN(b.x)]) == gen, bar);
            __builtin_amdgcn_fence(__ATOMIC_ACQUIRE, "agent");
            asm volatile("s_waitcnt vmcnt(0)" ::: "memory");
        }
    }
    __syncthreads();
}

__global__ void __launch_bounds__(512) mega(Params p) {
    extern __shared__ __attribute__((aligned(16))) unsigned char lds_raw[];
    LAS unsigned char* lds = (LAS unsigned char*)lds_raw;
    cg::grid_group grid = cg::this_grid();
    const int lo = p.ph_lo, hi = p.ph_hi, G = gridDim.x, wg = blockIdx.x, tid = threadIdx.x, wid = tid >> 6;
    unsigned char* ws = p.ws;
#ifndef ONLY
#define ONLY -1
#endif
#define IN(k) ((ONLY < 0 || ONLY == (k)) && lo <= (k) && (k) <= hi)
#define SEAM(k) do { if (lo <= (k) && (k) < hi) xcd_barrier(xb); } while (0)
    if (lo < 0) grid.sync();
    XcdBarrier xb; xb.bar = (unsigned*)(ws + OFF_BAR); xb.x = 0; xb.st = (volatile LAS unsigned*)(lds + 131072);
    if (lo < hi) {
        if (tid < 2) xb.st[tid] = 0u;
        __syncthreads();
        xb = xcd_barrier_post((unsigned*)(ws + OFF_BAR), (volatile LAS unsigned*)(lds + 131072));
    }
    if (IN(0)) phase0(p, lds);
    SEAM(0);
    if (IN(1)) {
        {
            const int lane = tid & 63, fr = lane & 15, fq = lane >> 4;
            const bf16_t* xn = (const bf16_t*)(ws + OFF_XN); const bf16_t* wdt = (const bf16_t*)(ws + OFF_WDT); float* dtv = (float*)(ws + OFF_DTV);
            for (int rt = wg * 8 + wid; rt < T_TOK / 16; rt += G * 8) {
                f32x4 a0 = (f32x4){0.f, 0.f, 0.f, 0.f}, a1 = a0;
                const bf16_t* xr = xn + (size_t)(rt * 16 + fr) * 1024 + fq * 8; const bf16_t* w0 = wdt + (size_t)fr * 1024 + fq * 8; const bf16_t* w1 = w0 + 16 * 1024;
#pragma unroll 8
                for (int kk = 0; kk < 32; ++kk) { const bf16x8 xa = *(const bf16x8*)(xr + kk * 32), b0 = *(const bf16x8*)(w0 + kk * 32), b1 = *(const bf16x8*)(w1 + kk * 32);
                    a0 = __builtin_amdgcn_mfma_f32_16x16x32_bf16(b0, xa, a0, 0, 0, 0); a1 = __builtin_amdgcn_mfma_f32_16x16x32_bf16(b1, xa, a1, 0, 0, 0); }
                float* dr = dtv + (size_t)(rt * 16 + fr) * 24 + 4 * fq; f32x4 o0, o1;
#pragma unroll
                for (int j = 0; j < 4; ++j) { o0[j] = softplusf_(a0[j] + p.dtbias[4 * fq + j]); o1[j] = softplusf_(a1[j] + p.dtbias[(16 + 4 * fq + j) % 24]); }
                *(f32x4*)dr = o0; if (fq < 2) *(f32x4*)(dr + 16) = o1;
            }
        }
        pg8::Gemm g{(const bf16_t*)(ws + OFF_XN), (const bf16_t*)(ws + OFF_WIN), 1024, 1024, T_TOK, N_INP, 1024}; pg8::StaticOrder S; S.init(T_TOK, N_INP, G, wg);
        EpiInProj E{(bf16_t*)(ws + OFF_SEGA), (bf16_t*)(ws + OFF_SEGB), (bf16_t*)p.out, (float*)(ws + OFF_DTV), p.dtbias, p.dry};
        pg8::gemm_phase(lds, g, S, E);
    }
    SEAM(1);
    if (IN(2)) {
        if (!(p.dry & 32)) for (int it = wg; it < 1024; it += G) { if (it == wg || (G & 3)) conv_fill(p, lds, it & 3); ssd_states_item(p, lds, it); }
        for (int it = wg * 8 + wid; it < 8192; it += G * 8) if (((it >> 5) & 15) != 15) s5_wave_item<1>(p, (LAS float*)(lds + wid * 8448), it);
    }
    SEAM(2);
    if (IN(3)) {
        const bool s5first = (wg & 1) != 0;
        if (!s5first) ssd_prefix(p);
        for (int it = wg * 8 + wid; it < 8192; it += G * 8) s5_wave_item<2>(p, (LAS float*)(lds + wid * 8448), it);
        if (s5first) ssd_prefix(p);
        __syncthreads();
        xpose_tiles<0>(p.wbr5, 1024, 512, (bf16_t*)(ws + OFF_W5T), 1024, nullptr, (LAS float*)lds, wg, G);
        xpose_tiles<0>(p.wbrs, 1024, 1536, (bf16_t*)(ws + OFF_WSST), 1024, nullptr, (LAS float*)lds, wg, G);
        xpose_tiles<0>(p.wout, 1024, 1024, (bf16_t*)(ws + OFF_WOUTT), 1024, nullptr, (LAS float*)lds, wg, G);
        xpose_tiles<0>(p.wpg, 1024, 1024, (bf16_t*)(ws + OFF_WPGT), 1024, p.plenw, (LAS float*)lds, wg, G);
        xpose_tiles<0>(p.wpp, 1024, 256, (bf16_t*)(ws + OFF_WPPT), 1024, nullptr, (LAS float*)lds, wg, G);
        { bf16_t* pbf = (bf16_t*)(ws + OFF_PBF); const int nthr = G * 512;
          for (int v = wg * 512 + tid; v < T_TOK * 256 / 8; v += nthr) { const f32x4 a = *(const f32x4*)(p.p + (size_t)v * 8), bq = *(const f32x4*)(p.p + (size_t)v * 8 + 4);
              u32x4 w; w.x = pk2(a[0], a[1]); w.y = pk2(a[2], a[3]); w.z = pk2(bq[0], bq[1]); w.w = pk2(bq[2], bq[3]); *(u32x4*)(pbf + (size_t)v * 8) = w; } }
    }
    SEAM(3);
    if (IN(4)) {
        { pg8::Gemm g{(const bf16_t*)(ws + OFF_SEGA), (const bf16_t*)(ws + OFF_WGLU), LDA_SEG, 512, T_TOK, 512, 512}; pg8::StaticOrder S; S.init(T_TOK, 512, G, wg);
          EpiGlu E{(bf16_t*)(ws + OFF_SEGA), p.bglu}; pg8::gemm_phase(lds, g, S, E); }
        __syncthreads();
#ifndef NO_SSD_OUT
        if (p.dry != 2) for (int it = wg; it < 1024; it += G) { if (it == wg || (G & 3)) conv_fill(p, lds, it & 3); ssd_out_item(p, lds, it); }
#endif
    }
    SEAM(4);
    if (IN(6)) {
        { pg8::Gemm g{(const bf16_t*)(ws + OFF_SEGA) + 512, (const bf16_t*)(ws + OFF_W5T), LDA_SEG, 512, T_TOK, 1024, 512}; pg8::StaticOrder S; S.init(T_TOK, 1024, G, wg);
          EpiMerge<0> E{(bf16_t*)(ws + OFF_M5), (const bf16_t*)p.out, nullptr}; pg8::gemm_phase(lds, g, S, E); }
        { pg8::Gemm g{(const bf16_t*)(ws + OFF_SEGA) + 1024, (const bf16_t*)(ws + OFF_WSST), LDA_SEG, 1536, T_TOK, 1024, 1536}; pg8::StaticOrder S; S.init(T_TOK, 1024, G, wg);
          EpiMerge<1> E{(bf16_t*)(ws + OFF_MERGED), (const bf16_t*)p.out, (const bf16_t*)(ws + OFF_M5)}; pg8::gemm_phase(lds, g, S, E); }
    }
    SEAM(6);
    if (IN(7)) {
        pg8::Gemm g{(const bf16_t*)(ws + OFF_MERGED), (const bf16_t*)(ws + OFF_WOUTT), 1024, 1024, T_TOK, 1024, 1024}; pg8::StaticOrder S; S.init(T_TOK, 1024, G, wg);
        EpiOut E{p.x, (bf16_t*)(ws + OFF_M5), (float*)(ws + OFF_SS1)}; pg8::gemm_phase(lds, g, S, E);
    }
    SEAM(7);
    if (IN(8)) {
        { pg8::Gemm g{(const bf16_t*)(ws + OFF_PBF), (const bf16_t*)(ws + OFF_WPPT), 256, 256, T_TOK, 1024, 256}; pg8::StaticOrder S; S.init(T_TOK, 1024, G, wg);
          EpiMerge<2> E{(bf16_t*)(ws + OFF_PLEP), nullptr, nullptr}; pg8::gemm_phase(lds, g, S, E); }
        { pg8::Gemm g{(const bf16_t*)(ws + OFF_M5), (const bf16_t*)(ws + OFF_WPGT), 1024, 1024, T_TOK, 1024, 1024}; pg8::StaticOrder S; S.init(T_TOK, 1024, G, wg);
          EpiPle E{(const bf16_t*)(ws + OFF_M5), (bf16_t*)(ws + OFF_SEGA), (const bf16_t*)(ws + OFF_PLEP), (const float*)(ws + OFF_SS1), (float*)(ws + OFF_SS2)}; pg8::gemm_phase(lds, g, S, E); }
    }
    SEAM(8);
    if (IN(9)) {
        const int lane = tid & 63; const float* ss2 = (const float*)(ws + OFF_SS2);
        for (int row0 = (wg * 8 + wid) * 2; row0 < T_TOK; row0 += G * 16) {
            u32x2 hw[2][4]; float r[2];
#pragma unroll
            for (int rr = 0; rr < 2; ++rr) { const u32x2* hp2 = (const u32x2*)((const bf16_t*)(ws + OFF_SEGA) + (size_t)(row0 + rr) * DM);
#pragma unroll
                for (int i = 0; i < 4; ++i) hw[rr][i] = hp2[lane + 64 * i];
                float s = lane < 16 ? ss2[(size_t)(row0 + rr) * 16 + lane] : 0.f; s = wave_sum(s); r[rr] = rsqrtf(s * (1.0f / 1024.0f) + 1e-6f); }
#pragma unroll
            for (int i = 0; i < 4; ++i) { const f32x4 w = ((const f32x4*)p.fnw)[lane + 64 * i];
#pragma unroll
                for (int rr = 0; rr < 2; ++rr) { f32x4 v; v[0] = bflo(hw[rr][i].x) * r[rr] * w[0]; v[1] = bfhi(hw[rr][i].x) * r[rr] * w[1]; v[2] = bflo(hw[rr][i].y) * r[rr] * w[2]; v[3] = bfhi(hw[rr][i].y) * r[rr] * w[3];
                    ((f32x4*)(p.out + (size_t)(row0 + rr) * DM))[lane + 64 * i] = v; } }
        }
    }
#undef IN
#undef SEAM
}

#ifndef N_LAUNCH_MODE
#define N_LAUNCH_MODE 1
#endif
extern "C" void kernel_launch(void* const* d_in, const int* in_sizes, int n_in, void* d_out, int out_size, void* d_ws, size_t ws_size, hipStream_t stream) {
    static int grid = 0;
    if (grid == 0) {
        if (n_in != 27 || ws_size < WS_NEED) { fprintf(stderr, "kernel_launch: need 27 inputs and >= %zu bytes of workspace; got %d, %zu\n", (size_t)WS_NEED, n_in, ws_size); grid = -1; return; }
        int dev = 0, cus = 0, per_cu = 0;
        hipGetDevice(&dev); hipDeviceGetAttribute(&cus, hipDeviceAttributeMultiprocessorCount, dev);
        if (hipFuncSetAttribute((const void*)mega, hipFuncAttributeMaxDynamicSharedMemorySize, LDS_BYTES) != hipSuccess) { fprintf(stderr, "kernel_launch: hipFuncSetAttribute failed\n"); grid = -1; return; }
        if (hipOccupancyMaxActiveBlocksPerMultiprocessor(&per_cu, (const void*)mega, 512, LDS_BYTES) != hipSuccess || per_cu < 1) { fprintf(stderr, "kernel_launch: occupancy query says %d blocks per CU\n", per_cu); per_cu = 1; }
        (void)hipGetLastError();
        grid = cus;
    }
    if (grid < 0) return;
    Params p{};
    const float** pp = (const float**)&p;
    for (int i = 0; i < 27; ++i) pp[i] = (const float*)d_in[i];
    p.out = (float*)d_out; p.ws = (unsigned char*)d_ws;
#if N_LAUNCH_MODE == 1
    hipMemsetAsync((unsigned char*)d_ws + OFF_BAR, 0, XCD_BAR_WORDS * 4, stream);
    p.ph_lo = 0; p.ph_hi = 9;
    void* args[] = {&p};
    hipError_t e = hipLaunchCooperativeKernel((const void*)mega, dim3(grid), dim3(512), args, LDS_BYTES, stream);
    if (e != hipSuccess) fprintf(stderr, "cooperative launch failed: %s (grid %d)\n", hipGetErrorString(e), grid);
#else
#ifndef PROBE_DUP2
#define PROBE_DUP2 -1
#endif
#ifndef PROBE_DUP
#define PROBE_DUP -1
#endif
#ifndef PROBE_DRY4
#define PROBE_DRY4 0
#endif
    for (int k = 0; k < 10; ++k) { p.ph_lo = k; p.ph_hi = k;
#ifndef PROBE_DRY1
#define PROBE_DRY1 0
#endif
#ifndef PROBE_DRY2
#define PROBE_DRY2 0
#endif
        if (k == 2 && PROBE_DRY2) { p.dry = 32; hipLaunchKernelGGL(mega, dim3(grid), dim3(512), LDS_BYTES, stream, p); p.dry = 0; }
        if (k == 1 && PROBE_DRY1) { p.dry = 4; hipLaunchKernelGGL(mega, dim3(grid), dim3(512), LDS_BYTES, stream, p); p.dry = 0; }
        if (k == 4 && PROBE_DRY4) { p.dry = PROBE_DRY4; hipLaunchKernelGGL(mega, dim3(grid), dim3(512), LDS_BYTES, stream, p); p.dry = 0; }
        hipLaunchKernelGGL(mega, dim3(grid), dim3(512), LDS_BYTES, stream, p);
        if (k == PROBE_DUP || k == PROBE_DUP2) hipLaunchKernelGGL(mega, dim3(grid), dim3(512), LDS_BYTES, stream, p); }
#endif
}
```

```cpp
#include <hip/hip_runtime.h>
#include <hip/hip_cooperative_groups.h>
#include <cstdio>
namespace cg = cooperative_groups;

#define LAS __attribute__((address_space(3)))
typedef unsigned short bf16_t;
typedef short bf16x8 __attribute__((ext_vector_type(8)));
typedef float f32x4 __attribute__((ext_vector_type(4)));
typedef float f32x2 __attribute__((ext_vector_type(2)));
typedef unsigned u32x4 __attribute__((ext_vector_type(4)));
typedef unsigned u32x2 __attribute__((ext_vector_type(2)));

constexpr int T_TOK = 32768, DM = 1024, SEQ = 2048, NBATCH = 16, NCHUNK = 16, CH = 128;
constexpr int LDA_SEG = 2560;
constexpr int N_INP = 7168;
constexpr size_t MiB = 1ull << 20;
constexpr size_t OFF_SEGA = 0;
constexpr size_t OFF_SEGB = 160 * MiB;
constexpr size_t OFF_STATES = 320 * MiB;
constexpr size_t OFF_XN = 416 * MiB;
constexpr size_t OFF_WIN = 480 * MiB;
constexpr size_t OFF_DTV = 495 * MiB;
constexpr size_t OFF_E = 498 * MiB;
constexpr size_t OFF_TAB = 502 * MiB;
constexpr size_t OFF_WGLU = OFF_TAB;
constexpr size_t OFF_LAM = OFF_TAB + 512 * 1024;
constexpr size_t OFF_LAML = OFF_LAM + 16 * 1024;
constexpr size_t OFF_BBT = OFF_LAML + 16 * 1024;
constexpr size_t OFF_CWT = OFF_BBT + 256 * 1024;
constexpr size_t OFF_CDEC = OFF_CWT + 128 * 1024;
constexpr size_t OFF_BAR = OFF_CDEC + 32 * 1024;
constexpr size_t OFF_WDT = OFF_BAR + 16 * 1024;
constexpr size_t WS_NEED = 504 * MiB;
constexpr size_t OFF_M5 = OFF_SEGB;
constexpr size_t OFF_MERGED = OFF_SEGB + 64 * MiB;
constexpr size_t OFF_PBF = OFF_XN + 8 * MiB;
constexpr size_t OFF_W5T = OFF_XN + 24 * MiB;
constexpr size_t OFF_WSST = OFF_XN + 25 * MiB;
constexpr size_t OFF_WOUTT = OFF_XN + 28 * MiB;
constexpr size_t OFF_WPGT = OFF_XN + 30 * MiB;
constexpr size_t OFF_WPPT = OFF_XN + 32 * MiB;
constexpr size_t OFF_PLEP = OFF_STATES;
constexpr size_t OFF_SS1 = OFF_XN;
constexpr size_t OFF_SS2 = OFF_XN + 2 * MiB;

constexpr int LDS_BYTES = 131072 + 16;

struct Params {
    const float *x, *p, *norm_w, *w_in, *a_re, *a_im, *b_re, *b_im, *c_re, *c_im, *s5d, *logstep, *wglu, *bglu,
        *convw, *convb, *dtbias, *alog, *ssdd, *ssdnw, *wbr5, *wbrs, *wout, *plenw, *wpg, *wpp, *fnw;
    float* out; unsigned char* ws; int ph_lo, ph_hi, dry, pad;
};

typedef __bf16 bf16x2_t __attribute__((ext_vector_type(2)));
__device__ __forceinline__ unsigned pk2(float lo, float hi) { f32x2 v = {lo, hi}; bf16x2_t r = __builtin_convertvector(v, bf16x2_t); unsigned u; __builtin_memcpy(&u, &r, 4); return u; }
__device__ __forceinline__ float bflo(unsigned w) { return __uint_as_float(w << 16); }
__device__ __forceinline__ float bfhi(unsigned w) { return __uint_as_float(w & 0xffff0000u); }
__device__ __forceinline__ float sigmoidf_(float v) { return __builtin_amdgcn_rcpf(1.0f + __expf(-v)); }
__device__ __forceinline__ float siluf_(float v) { return v * __builtin_amdgcn_rcpf(1.0f + __expf(-v)); }
__device__ __forceinline__ float softplusf_(float v) { return fmaxf(v, 0.f) + log1pf(__expf(-fabsf(v))); }
__device__ __forceinline__ float geluf_(float v) { const float u = 0.7978845608028654f * (v + 0.044715f * v * v * v); const float t = 1.0f - 2.0f * __builtin_amdgcn_rcpf(1.0f + __expf(2.0f * u)); return 0.5f * v * (1.0f + t); }
__device__ __forceinline__ float wave_sum(float s) {
#pragma unroll
    for (int o = 32; o > 0; o >>= 1) s += __shfl_xor(s, o);
    return s;
}
__device__ __forceinline__ void unpack8(const u32x4 w, float (&f)[8]) { f[0] = bflo(w.x); f[1] = bfhi(w.x); f[2] = bflo(w.y); f[3] = bfhi(w.y); f[4] = bflo(w.z); f[5] = bfhi(w.z); f[6] = bflo(w.w); f[7] = bfhi(w.w); }
__device__ __forceinline__ u32x4 pack8(const float (&f)[8]) { u32x4 w; w.x = pk2(f[0], f[1]); w.y = pk2(f[2], f[3]); w.z = pk2(f[4], f[5]); w.w = pk2(f[6], f[7]); return w; }

namespace pg8 {
constexpr int BM = 256, BK = 64, HALF = 128, HTB = HALF * BK * 2, STAGE_BYTES = 8 * HTB, NXCD = 8, WGM = 8;
__device__ __forceinline__ int lds_byte(int r, int c) { const int st = (r >> 4) * 2 + (c >> 5), rr = r & 15, cc = c & 31, ob = rr * 64 + cc * 2; return st * 1024 + (ob ^ (((ob >> 9) & 1) << 5)); }
__device__ __forceinline__ void stage_rc(int b, int& R, int& C) { const int st = b / 1024, sb = b % 1024, swz = sb ^ (((sb >> 9) & 1) << 5); R = (st >> 1) * 16 + swz / 64; C = (st & 1) * 32 + (swz % 64) / 2; }
__device__ __forceinline__ int perm32(int rho) { const int n = rho >> 4, i = rho & 15; return 8 * (i >> 2) + 4 * n + (i & 3); }
struct Unit { int pm, pn; };
struct Gemm { const bf16_t* A; const bf16_t* Bt; int lda, ldb, M, N, K; };
struct StaticOrder {
    int nM, nN, nwg, G, c;
    __device__ void init(int M, int N, int G_, int c_) { nM = M / BM; nN = N / BM; nwg = nM * nN; G = G_; c = c_; }
    __device__ bool next(int i, Unit& u) const {
        const long L = (long)i * G + c; if (L >= nwg) return false;
        int wgid = (int)L; { const int q = nwg / NXCD, r = nwg % NXCD, xcd = wgid % NXCD, off = wgid / NXCD; wgid = (xcd < r ? xcd * (q + 1) : r * (q + 1) + (xcd - r) * q) + off; }
        const int nig = WGM * nN, gid = wgid / nig, fm = gid * WGM, gsz = (nM - fm) < WGM ? (nM - fm) : WGM;
        u.pm = fm + ((wgid % nig) % gsz); u.pn = (wgid % nig) / gsz; return true;
    }
};
template <class Epi>
__device__ __forceinline__ void gemm_phase(LAS unsigned char* lds, const Gemm g, const StaticOrder& S, const Epi& E) {
    const int tid = threadIdx.x, wid = __builtin_amdgcn_readfirstlane(tid >> 6), lane = tid & 63, wr = wid >> 2, wc = wid & 3, fr = lane & 15, fq = lane >> 4;
    const int K = g.K, nt = K / BK;
    unsigned voffA[2], voffB[2];
#pragma unroll
    for (int i = 0; i < 2; ++i) { int R, C; stage_rc(tid * 16 + i * 8192, R, C); const int Rb = (R & ~31) + perm32(R & 31);
        voffA[i] = (unsigned)(R * g.lda + C) * 2u; voffB[i] = (unsigned)(Rb * g.ldb + C) * 2u; }
    const size_t kstep = (size_t)(BK * 2);
    const size_t hstepA = (size_t)HALF * g.lda * 2, hstepB = (size_t)HALF * g.ldb * 2;
    const size_t tstepA = 2 * hstepA, tstepB = 2 * hstepB;
    const unsigned ldsw = (unsigned)wid * 1024u;
    const int aoff = lds_byte(wr * 64 + fr, fq * 8), boff = lds_byte(wc * 32 + fr, fq * 8);
#define PG8_SA(b, h) (((b) * 2 + (h)) * HTB)
#define PG8_SB(b, h) ((4 + (b) * 2 + (h)) * HTB)
#define PG8_STAGE(bufoff, gbase, voff) do { _Pragma("unroll") for (int _i = 0; _i < 2; ++_i) \
        __builtin_amdgcn_global_load_lds((const unsigned*)((const char*)(gbase) + (voff)[_i]), (LAS unsigned*)(lds + (bufoff) + ldsw + _i * 8192), 16, 0, 0); } while (0)
#define PG8_LDA(dst, b, h) do { _Pragma("unroll") for (int m = 0; m < 4; ++m) _Pragma("unroll") for (int k = 0; k < 2; ++k) dst[m][k] = *(const LAS bf16x8*)(lds + PG8_SA(b, h) + aoff + m * 2048 + k * 1024); } while (0)
#define PG8_LDB(dst, b, h) do { _Pragma("unroll") for (int n = 0; n < 2; ++n) _Pragma("unroll") for (int k = 0; k < 2; ++k) dst[n][k] = *(const LAS bf16x8*)(lds + PG8_SB(b, h) + boff + n * 2048 + k * 1024); } while (0)
#define PG8_MMA(ai, bj, At, Bt) do { __builtin_amdgcn_s_setprio(1); _Pragma("unroll") for (int m = 0; m < 4; ++m) _Pragma("unroll") for (int n = 0; n < 2; ++n) _Pragma("unroll") for (int k = 0; k < 2; ++k) \
        acc[ai][bj][m][n] = __builtin_amdgcn_mfma_f32_16x16x32_bf16(Bt[n][k], At[m][k], acc[ai][bj][m][n], 0, 0, 0); __builtin_amdgcn_s_setprio(0); } while (0)
#define PG8_WAIT_V(n) asm volatile("s_waitcnt vmcnt(" #n ")" ::: "memory")
#define PG8_WAIT_L(n) asm volatile("s_waitcnt lgkmcnt(" #n ")" ::: "memory")
#define PG8_BAR __builtin_amdgcn_s_barrier()
#define PG8_SCHED __builtin_amdgcn_sched_barrier(0)
    Unit cur, nxt; int ui = 0;
    if (!S.next(0, cur)) return;
    f32x4 acc[2][2][4][2];
#pragma unroll
    for (int a = 0; a < 2; ++a)
#pragma unroll
        for (int b = 0; b < 2; ++b)
#pragma unroll
            for (int m = 0; m < 4; ++m)
#pragma unroll
                for (int n = 0; n < 2; ++n) acc[a][b][m][n] = (f32x4){0.f, 0.f, 0.f, 0.f};
    bf16x8 At[4][2], B0[2][2], B1[2][2];
    const char* cA = (const char*)g.A + (size_t)cur.pm * tstepA; const char* cB = (const char*)g.Bt + (size_t)cur.pn * tstepB;
    PG8_STAGE(PG8_SB(0, 0), cB, voffB); PG8_STAGE(PG8_SA(0, 0), cA, voffA); PG8_STAGE(PG8_SB(0, 1), cB + hstepB, voffB); PG8_STAGE(PG8_SA(0, 1), cA + hstepA, voffA);
    if (wr == 1) PG8_BAR;
    PG8_WAIT_V(4); PG8_BAR;
    PG8_STAGE(PG8_SB(1, 0), cB + kstep, voffB); PG8_STAGE(PG8_SA(1, 0), cA + kstep, voffA); PG8_STAGE(PG8_SB(1, 1), cB + hstepB + kstep, voffB);
    PG8_WAIT_V(6); PG8_BAR;
    for (;;) {
        const bool has_next = S.next(ui + 1, nxt);
        const char* nA = has_next ? (const char*)g.A + (size_t)nxt.pm * tstepA : cA; const char* nB = has_next ? (const char*)g.Bt + (size_t)nxt.pn * tstepB : cB;
        for (int t = 0; t < nt; t += 2) {
            const bool last = (t == nt - 2);
            const char* a1 = cA + (size_t)(t + 1) * kstep;
            const char* a2 = last ? nA : cA + (size_t)(t + 2) * kstep; const char* b2 = last ? nB : cB + (size_t)(t + 2) * kstep;
            const char* a3 = a2 + kstep; const char* b3 = b2 + kstep;
            PG8_LDB(B0, 0, 0); PG8_SCHED; PG8_LDA(At, 0, 0); PG8_STAGE(PG8_SA(1, 1), a1 + hstepA, voffA);
            PG8_WAIT_L(8); PG8_BAR; PG8_WAIT_L(0); PG8_MMA(0, 0, At, B0); PG8_BAR; PG8_SCHED;
            PG8_LDB(B1, 0, 1); PG8_STAGE(PG8_SB(0, 0), b2, voffB);
            PG8_BAR; PG8_WAIT_L(0); PG8_MMA(0, 1, At, B1); PG8_BAR;
            PG8_LDA(At, 0, 1); PG8_STAGE(PG8_SA(0, 0), a2, voffA);
            PG8_BAR; PG8_WAIT_L(0); PG8_MMA(1, 0, At, B0); PG8_BAR; PG8_SCHED;
            PG8_STAGE(PG8_SB(0, 1), b2 + hstepB, voffB);
            PG8_WAIT_V(6); PG8_BAR; PG8_MMA(1, 1, At, B1); PG8_BAR;
            PG8_LDB(B0, 1, 0); PG8_SCHED; PG8_LDA(At, 1, 0); PG8_STAGE(PG8_SA(0, 1), a2 + hstepA, voffA);
            PG8_WAIT_L(8); PG8_BAR; PG8_WAIT_L(0); PG8_MMA(0, 0, At, B0); PG8_BAR; PG8_SCHED;
            PG8_LDB(B1, 1, 1); PG8_STAGE(PG8_SB(1, 0), b3, voffB);
            PG8_BAR; PG8_WAIT_L(0); PG8_MMA(0, 1, At, B1); PG8_BAR;
            PG8_LDA(At, 1, 1); PG8_STAGE(PG8_SA(1, 0), a3, voffA);
            PG8_BAR; PG8_WAIT_L(0); PG8_MMA(1, 0, At, B0); PG8_BAR; PG8_SCHED;
            PG8_STAGE(PG8_SB(1, 1), b3 + hstepB, voffB);
            PG8_WAIT_V(6); PG8_BAR; PG8_MMA(1, 1, At, B1); PG8_BAR;
        }
        E(acc, cur, wr, wc, fr, fq);
        if (!has_next) break;
#pragma unroll
        for (int a = 0; a < 2; ++a)
#pragma unroll
            for (int b = 0; b < 2; ++b)
#pragma unroll
                for (int m = 0; m < 4; ++m)
#pragma unroll
                    for (int n = 0; n < 2; ++n) acc[a][b][m][n] = (f32x4){0.f, 0.f, 0.f, 0.f};
        cur = nxt; cA = nA; cB = nB; ++ui;
    }
    PG8_WAIT_V(0);
    if (wr == 0) PG8_BAR;
    PG8_BAR;
#undef PG8_SA
#undef PG8_SB
#undef PG8_STAGE
#undef PG8_LDA
#undef PG8_LDB
#undef PG8_MMA
#undef PG8_WAIT_V
#undef PG8_WAIT_L
#undef PG8_BAR
#undef PG8_SCHED
}
}
typedef f32x4 AccT[2][2][4][2];

struct EpiInProj {
    bf16_t *segA, *segB, *gates; float* dtv; const float* dtbias; int dry;
    __device__ __forceinline__ void operator()(const AccT& acc, const pg8::Unit& u, int wr, int wc, int fr, int fq) const {
        if (dry & 4) return;
        const int pn = u.pn, row0 = u.pm * 256 + wr * 64 + fr;
        {
            bf16_t* base; int ld, colt, act;
            if (pn < 10) { base = segA; ld = LDA_SEG; colt = pn * 256; act = 0; }
            else if (pn < 20) { base = segB; ld = LDA_SEG; colt = (pn - 10) * 256; act = 0; }
            else { base = gates; ld = 2048; colt = (pn - 20) * 256; act = 2; }
            const int col0 = colt + wc * 32 + 8 * fq;
#pragma unroll
            for (int ai = 0; ai < 2; ++ai)
#pragma unroll
                for (int m = 0; m < 4; ++m) { bf16_t* rowp = base + (size_t)(row0 + ai * 128 + m * 16) * ld + col0;
#pragma unroll
                    for (int bj = 0; bj < 2; ++bj) { f32x4 v0 = acc[ai][bj][m][0], v1 = acc[ai][bj][m][1];
                        if (act == 1) {
#pragma unroll
                            for (int j = 0; j < 4; ++j) { v0[j] = siluf_(v0[j]); v1[j] = siluf_(v1[j]); } }
                        if (act == 2) {
#pragma unroll
                            for (int j = 0; j < 4; ++j) { v0[j] = sigmoidf_(v0[j]); v1[j] = sigmoidf_(v1[j]); } }
                        u32x4 w; w.x = pk2(v0[0], v0[1]); w.y = pk2(v0[2], v0[3]); w.z = pk2(v1[0], v1[1]); w.w = pk2(v1[2], v1[3]);
                        *(u32x4*)(rowp + bj * 128) = w; } }
        }
    }
};
struct EpiGlu {
    bf16_t* segA; const float* bglu;
    __device__ __forceinline__ void operator()(const AccT& acc, const pg8::Unit& u, int wr, int wc, int fr, int fq) const {
        const int row0 = u.pm * 256 + wr * 64 + fr, col0 = u.pn * 256 + wc * 32 + 8 * fq;
        f32x4 bb[2][2];
#pragma unroll
        for (int bj = 0; bj < 2; ++bj) { bb[bj][0] = *(const f32x4*)(bglu + col0 + bj * 128); bb[bj][1] = *(const f32x4*)(bglu + col0 + bj * 128 + 4); }
#pragma unroll
        for (int ai = 0; ai < 2; ++ai) {
            u32x4 yw[4][2], zw[4][2];
#pragma unroll
            for (int m = 0; m < 4; ++m)
#pragma unroll
                for (int bj = 0; bj < 2; ++bj) { const bf16_t* rowp = segA + (size_t)(row0 + ai * 128 + m * 16) * LDA_SEG + col0 + bj * 128; yw[m][bj] = *(const u32x4*)rowp; zw[m][bj] = *(const u32x4*)(rowp + 512); }
#pragma unroll
            for (int m = 0; m < 4; ++m)
#pragma unroll
                for (int bj = 0; bj < 2; ++bj) { bf16_t* rowp = segA + (size_t)(row0 + ai * 128 + m * 16) * LDA_SEG + col0 + bj * 128;
                    float y[8], z[8], o[8]; unpack8(yw[m][bj], y); unpack8(zw[m][bj], z);
#pragma unroll
                    for (int j = 0; j < 4; ++j) { o[j] = y[j] * sigmoidf_(acc[ai][bj][m][0][j] + bb[bj][0][j]) * siluf_(z[j]); o[4 + j] = y[4 + j] * sigmoidf_(acc[ai][bj][m][1][j] + bb[bj][1][j]) * siluf_(z[4 + j]); }
                    *(u32x4*)(rowp + 512) = pack8(o); }
            asm volatile("" ::: "memory"); }
    }
};
template <int MODE> struct EpiMerge {
    bf16_t* dst; const bf16_t* gates; const bf16_t* m5;
    __device__ __forceinline__ void operator()(const AccT& acc, const pg8::Unit& u, int wr, int wc, int fr, int fq) const {
        const int row0 = u.pm * 256 + wr * 64 + fr, col0 = u.pn * 256 + wc * 32 + 8 * fq;
#pragma unroll
        for (int ai = 0; ai < 2; ++ai) {
            u32x4 gw[4][2], mw[4][2];
            if (MODE != 2) {
#pragma unroll
                for (int m = 0; m < 4; ++m)
#pragma unroll
                    for (int bj = 0; bj < 2; ++bj) { const size_t r = (size_t)(row0 + ai * 128 + m * 16); const int c = col0 + bj * 128;
                        gw[m][bj] = *(const u32x4*)(gates + r * 2048 + (MODE == 1 ? 1024 : 0) + c); if (MODE == 1) mw[m][bj] = *(const u32x4*)(m5 + r * 1024 + c); } }
#pragma unroll
            for (int m = 0; m < 4; ++m)
#pragma unroll
                for (int bj = 0; bj < 2; ++bj) { const size_t r = (size_t)(row0 + ai * 128 + m * 16); const int c = col0 + bj * 128;
                    float o[8];
#pragma unroll
                    for (int j = 0; j < 4; ++j) { o[j] = acc[ai][bj][m][0][j]; o[4 + j] = acc[ai][bj][m][1][j]; }
                    if (MODE == 0) { float gt[8]; unpack8(gw[m][bj], gt);
#pragma unroll
                        for (int j = 0; j < 8; ++j) o[j] *= gt[j]; }
                    if (MODE == 1) { float gt[8], mm[8]; unpack8(gw[m][bj], gt); unpack8(mw[m][bj], mm);
#pragma unroll
                        for (int j = 0; j < 8; ++j) o[j] = mm[j] + gt[j] * o[j]; }
                    *(u32x4*)(dst + r * 1024 + c) = pack8(o); }
            asm volatile("" ::: "memory"); }
    }
};
struct EpiOut {
    const float* x; bf16_t* hbf; float* ss;
    __device__ __forceinline__ void operator()(const AccT& acc, const pg8::Unit& u, int wr, int wc, int fr, int fq) const {
        const int row0 = u.pm * 256 + wr * 64 + fr, col0 = u.pn * 256 + wc * 32 + 8 * fq;
#pragma unroll
        for (int ai = 0; ai < 2; ++ai) {
            f32x4 xv[4][2][2];
#pragma unroll
            for (int m = 0; m < 4; ++m)
#pragma unroll
                for (int bj = 0; bj < 2; ++bj) { const float* xp = x + (size_t)(row0 + ai * 128 + m * 16) * 1024 + col0 + bj * 128; xv[m][bj][0] = *(const f32x4*)xp; xv[m][bj][1] = *(const f32x4*)(xp + 4); }
#pragma unroll
            for (int m = 0; m < 4; ++m) { const size_t r = (size_t)(row0 + ai * 128 + m * 16); float s = 0.f;
#pragma unroll
                for (int bj = 0; bj < 2; ++bj) { const int c = col0 + bj * 128;
                    const f32x4 h0 = xv[m][bj][0] + acc[ai][bj][m][0], h1 = xv[m][bj][1] + acc[ai][bj][m][1];
                    u32x4 w; w.x = pk2(h0[0], h0[1]); w.y = pk2(h0[2], h0[3]); w.z = pk2(h1[0], h1[1]); w.w = pk2(h1[2], h1[3]);
                    *(u32x4*)(hbf + r * 1024 + c) = w;
#pragma unroll
                    for (int j = 0; j < 4; ++j) s += h0[j] * h0[j] + h1[j] * h1[j]; }
                s += __shfl_xor(s, 16); s += __shfl_xor(s, 32);
                if (fq == 0) ss[r * 16 + u.pn * 4 + wc] = s; }
            asm volatile("" ::: "memory"); }
    }
};
struct EpiPle {
    const bf16_t* h1bf; bf16_t* h2bf; const bf16_t* plep; const float* ss1; float* ss2;
    __device__ __forceinline__ void operator()(const AccT& acc, const pg8::Unit& u, int wr, int wc, int fr, int fq) const {
        const int row0 = u.pm * 256 + wr * 64 + fr, col0 = u.pn * 256 + wc * 32 + 8 * fq;
#pragma unroll
        for (int ai = 0; ai < 2; ++ai)
#pragma unroll
            for (int mp = 0; mp < 2; ++mp) {
                f32x4 q[2][4]; u32x4 pw[2][2], hw[2][2];
#pragma unroll
                for (int mm = 0; mm < 2; ++mm) { const size_t r = (size_t)(row0 + ai * 128 + (2 * mp + mm) * 16);
#pragma unroll
                    for (int k = 0; k < 4; ++k) q[mm][k] = *(const f32x4*)(ss1 + r * 16 + 4 * k);
#pragma unroll
                    for (int bj = 0; bj < 2; ++bj) { const size_t o = r * 1024 + col0 + bj * 128; pw[mm][bj] = *(const u32x4*)(plep + o); hw[mm][bj] = *(const u32x4*)(h1bf + o); } }
#pragma unroll
                for (int mm = 0; mm < 2; ++mm) { const int m = 2 * mp + mm; const size_t r = (size_t)(row0 + ai * 128 + m * 16); float s = 0.f;
                    const f32x4 qs = (q[mm][0] + q[mm][1]) + (q[mm][2] + q[mm][3]);
                    const float rstd = rsqrtf(((qs[0] + qs[1]) + (qs[2] + qs[3])) * (1.0f / 1024.0f) + 1e-6f);
#pragma unroll
                    for (int bj = 0; bj < 2; ++bj) { const int c = col0 + bj * 128;
                        float pp[8], hh[8]; unpack8(pw[mm][bj], pp); unpack8(hw[mm][bj], hh);
#pragma unroll
                        for (int j = 0; j < 4; ++j) { hh[j] += sigmoidf_(rstd * acc[ai][bj][m][0][j]) * pp[j]; hh[4 + j] += sigmoidf_(rstd * acc[ai][bj][m][1][j]) * pp[4 + j]; }
                        *(u32x4*)(h2bf + r * 1024 + c) = pack8(hh);
#pragma unroll
                        for (int j = 0; j < 8; ++j) s += hh[j] * hh[j]; }
                    s += __shfl_xor(s, 16); s += __shfl_xor(s, 32);
                    if (fq == 0) ss2[r * 16 + u.pn * 4 + wc] = s; }
                asm volatile("" ::: "memory"); }
    }
};

template <int MODE>
__device__ __forceinline__ void xpose_tiles(const float* __restrict__ src, int ldn, int K, bf16_t* __restrict__ dst, int Ndst, const float* __restrict__ kscale, LAS float* tile, int wg, int nwg) {
    const int nkt = K / 64, ntile = nkt * (Ndst / 64);
    for (int t = wg; t < ntile; t += nwg) {
        const int n0 = (t / nkt) * 64, k0 = (t % nkt) * 64;
        { const int r = threadIdx.x >> 4, c4 = (threadIdx.x & 15) * 4;
#pragma unroll
          for (int i = 0; i < 2; ++i) { const int k = k0 + r + 32 * i, n = n0 + c4; int sc = n;
              if (MODE == 1) sc = n < 5120 ? n : n + 24;
              if (MODE == 2) sc = n < 24 ? 5120 + n : -1;
              f32x4 v = (f32x4){0.f, 0.f, 0.f, 0.f};
              if (sc >= 0) v = *(const f32x4*)(src + (size_t)k * ldn + sc);
              if (kscale) v *= kscale[k];
              LAS float* tp = tile + (r + 32 * i) * 65 + c4; tp[0] = v[0]; tp[1] = v[1]; tp[2] = v[2]; tp[3] = v[3]; } }
        __syncthreads();
        { const int n = threadIdx.x >> 3, k8 = (threadIdx.x & 7) * 8; float f[8];
#pragma unroll
          for (int j = 0; j < 8; ++j) f[j] = tile[(k8 + j) * 65 + n];
          *(u32x4*)(dst + (size_t)(n0 + n) * K + k0 + k8) = pack8(f); }
        __syncthreads();
    }
}

__device__ __forceinline__ void dsincos(double x, double& s, double& c) {
    const double twopi = 6.283185307179586476925, hp = 1.5707963267948966192;
    x -= rint(x / twopi) * twopi;
    const double q = rint(x / hp); const double r = x - q * hp; const int qi = ((int)q) & 3;
    const double r2 = r * r;
    double sn = r * (1.0 + r2 * (-1.0 / 6 + r2 * (1.0 / 120 + r2 * (-1.0 / 5040 + r2 * (1.0 / 362880 + r2 * (-1.0 / 39916800 + r2 * (1.0 / 6227020800.0)))))));
    double cs = 1.0 + r2 * (-0.5 + r2 * (1.0 / 24 + r2 * (-1.0 / 720 + r2 * (1.0 / 40320 + r2 * (-1.0 / 3628800 + r2 * (1.0 / 479001600.0 + r2 * (-1.0 / 87178291200.0)))))));
    if (qi == 0) { s = sn; c = cs; } else if (qi == 1) { s = cs; c = -sn; } else if (qi == 2) { s = -sn; c = -cs; } else { s = -cs; c = sn; }
}
__device__ __forceinline__ void phase0(const Params& p, LAS unsigned char* lds) {
    const int tid = threadIdx.x, lane = tid & 63, gw = blockIdx.x * 8 + (tid >> 6), nw = gridDim.x * 8;
    bf16_t* xn = (bf16_t*)(p.ws + OFF_XN);
    for (int row0 = gw * 4; row0 < T_TOK; row0 += nw * 4) {
        f32x4 v[4][4]; float ss[4];
#pragma unroll
        for (int rr = 0; rr < 4; ++rr) { const f32x4* xr = (const f32x4*)(p.x + (size_t)(row0 + rr) * DM);
#pragma unroll
            for (int i = 0; i < 4; ++i) v[rr][i] = xr[lane + 64 * i]; }
#pragma unroll
        for (int rr = 0; rr < 4; ++rr) { float a = 0.f;
#pragma unroll
            for (int i = 0; i < 4; ++i) a += (v[rr][i][0] * v[rr][i][0] + v[rr][i][1] * v[rr][i][1]) + (v[rr][i][2] * v[rr][i][2] + v[rr][i][3] * v[rr][i][3]);
            ss[rr] = rsqrtf(wave_sum(a) * (1.0f / 1024.0f) + 1e-6f); }
#pragma unroll
        for (int i = 0; i < 4; ++i) { const f32x4 w = ((const f32x4*)p.norm_w)[lane + 64 * i];
#pragma unroll
            for (int rr = 0; rr < 4; ++rr) { const float r = ss[rr]; u32x2 o; o.x = pk2(v[rr][i][0] * r * w[0], v[rr][i][1] * r * w[1]); o.y = pk2(v[rr][i][2] * r * w[2], v[rr][i][3] * r * w[3]);
                *(u32x2*)(xn + (size_t)(row0 + rr) * DM + 4 * (lane + 64 * i)) = o; } }
    }
    xpose_tiles<1>(p.w_in, 7192, 1024, (bf16_t*)(p.ws + OFF_WIN), N_INP, nullptr, (LAS float*)lds, blockIdx.x, gridDim.x);
    xpose_tiles<2>(p.w_in, 7192, 1024, (bf16_t*)(p.ws + OFF_WDT), 64, nullptr, (LAS float*)lds, blockIdx.x, gridDim.x);
    xpose_tiles<0>(p.wglu, 512, 512, (bf16_t*)(p.ws + OFF_WGLU), 512, nullptr, (LAS float*)lds, blockIdx.x, gridDim.x);
    for (int gt = gw; gt < 2048; gt += nw) {
        const int g = gt >> 6, pp = gt & 63;
        const double step = exp((double)p.logstep[g]), ar = p.a_re[gt], ai = p.a_im[gt];
        const double mag = exp(ar * step); double sn, cs; dsincos(ai * step, sn, cs);
        const double lr = mag * cs, li = mag * sn, den = ar * ar + ai * ai, nr = lr - 1.0, ni = li;
        const double fre = (nr * ar + ni * ai) / den, fim = (ni * ar - nr * ai) / den;
        double pr = lr, pi = li;
#pragma unroll
        for (int i = 0; i < 7; ++i) { const double t = pr * pr - pi * pi; pi = 2.0 * pr * pi; pr = t; }
        if (lane == 0) { float* lam = (float*)(p.ws + OFF_LAM); float* lamL = (float*)(p.ws + OFF_LAML);
            lam[gt * 2] = (float)lr; lam[gt * 2 + 1] = (float)li; lamL[gt * 2] = (float)pr; lamL[gt * 2 + 1] = (float)pi; }
        bf16_t* bbt = (bf16_t*)(p.ws + OFF_BBT) + (size_t)g * 128 * 32; bf16_t* cwt = (bf16_t*)(p.ws + OFF_CWT) + (size_t)g * 16 * 128;
        if (lane < 16) { const int h = lane;
            const double br = p.b_re[gt * 16 + h], bi = p.b_im[gt * 16 + h];
            bbt[pp * 32 + h] = (bf16_t)(pk2((float)(fre * br - fim * bi), 0.f) & 0xffffu);
            bbt[(64 + pp) * 32 + h] = (bf16_t)(pk2((float)(fre * bi + fim * br), 0.f) & 0xffffu);
            cwt[h * 128 + pp] = (bf16_t)(pk2(p.c_re[(g * 16 + h) * 64 + pp], 0.f) & 0xffffu);
            cwt[h * 128 + 64 + pp] = (bf16_t)(pk2(-p.c_im[(g * 16 + h) * 64 + pp], 0.f) & 0xffffu);
        } else if (lane < 32) { bbt[pp * 32 + lane] = 0; bbt[(64 + pp) * 32 + lane] = 0; }
    }
}

template <int NCH> struct ConvMap { static constexpr int NOCT = NCH / 8, RUNS = 512 / NOCT, RL = 128 / RUNS; };
__device__ __forceinline__ void conv_load(const Params& p, int b, int c, int ch0, u32x4 (&raw)[7]) {
    const int co = threadIdx.x & 15, t0 = (threadIdx.x >> 4) * 4, ch = ch0 + co * 8;
    const bf16_t* segB = (const bf16_t*)(p.ws + OFF_SEGB);
#pragma unroll
    for (int i = 0; i < 7; ++i) { const int l = c * CH + t0 - 3 + i;
        raw[i] = (u32x4){0u, 0u, 0u, 0u};
        if (l >= 0) raw[i] = *(const u32x4*)(segB + (size_t)(b * SEQ + l) * LDA_SEG + ch); }
}
constexpr int CW_OFF = 112640;
__device__ __forceinline__ void conv_fill(const Params& p, LAS unsigned char* lds, int g) {
    LAS float* cw = (LAS float*)(lds + CW_OFF);
    for (int idx = threadIdx.x; idx < 5 * 5 * 128; idx += 512) { const int tile = idx / 640, k = (idx % 640) >> 7, ch = idx & 127;
        const int cb = tile < 3 ? (g * 6 + 2 * tile) * 64 : (tile == 3 ? 1536 + g * 128 : 2048 + g * 128);
        cw[idx] = k < 4 ? p.convw[k * 2560 + cb + ch] : p.convb[cb + ch]; }
    __syncthreads();
}
__device__ __forceinline__ void conv_compute(const LAS float* cwt  , const u32x4 (&raw)[7], float (&o)[4][8], int& t0, int& co) {
    co = threadIdx.x & 15; t0 = (threadIdx.x >> 4) * 4;
    float xr[7][8];
#pragma unroll
    for (int i = 0; i < 7; ++i) unpack8(raw[i], xr[i]);
    float cb[8];
    { const f32x4 b0 = *(const LAS f32x4*)(cwt + 4 * 128 + co * 8), b1 = *(const LAS f32x4*)(cwt + 4 * 128 + co * 8 + 4);
#pragma unroll
      for (int j = 0; j < 4; ++j) { cb[j] = b0[j]; cb[4 + j] = b1[j]; } }
#pragma unroll
    for (int i = 0; i < 4; ++i)
#pragma unroll
        for (int e = 0; e < 8; ++e) o[i][e] = cb[e];
#pragma unroll
    for (int k = 0; k < 4; ++k) { const f32x4 w0 = *(const LAS f32x4*)(cwt + k * 128 + co * 8), w1 = *(const LAS f32x4*)(cwt + k * 128 + co * 8 + 4);
#pragma unroll
        for (int i = 0; i < 4; ++i) {
#pragma unroll
            for (int j = 0; j < 4; ++j) { o[i][j] += w0[j] * xr[i + k][j]; o[i][4 + j] += w1[j] * xr[i + k][4 + j]; } } }
#pragma unroll
    for (int i = 0; i < 4; ++i)
#pragma unroll
        for (int e = 0; e < 8; ++e) o[i][e] = siluf_(o[i][e]);
}

constexpr int LP = 136;
__device__ __forceinline__ int tsw_w(int row, int t0) { return row * LP + ((((t0 >> 3) ^ (row >> 3)) & 15) << 3) + (t0 & 7); }
__device__ __forceinline__ int tsw_r(int row, int kb) { return row * LP + (((kb ^ (row >> 3)) & 15) << 3); }
__device__ __forceinline__ void ssd_acum(const Params& p, int b, int c, int g, LAS float* acum, LAS float* dts) {
    const int wid = threadIdx.x >> 6, lane = threadIdx.x & 63;
    if (wid < 6) {
        const int h = g * 6 + wid; const float A = -__expf(p.alog[h]);
        const float* dtv = (const float*)(p.ws + OFF_DTV) + (size_t)(b * SEQ + c * CH) * 24 + h;
        const float v0 = dtv[(2 * lane) * 24], v1 = dtv[(2 * lane + 1) * 24];
        const float d0 = v0 * A, d1 = v1 * A; float s = d0 + d1, inc = s;
#pragma unroll
        for (int o = 1; o < 64; o <<= 1) { const float t = __shfl_up(inc, o); if (lane >= o) inc += t; }
        const float ex = inc - s;
        acum[wid * 128 + 2 * lane] = ex + d0; acum[wid * 128 + 2 * lane + 1] = ex + d0 + d1;
        dts[wid * 128 + 2 * lane] = v0; dts[wid * 128 + 2 * lane + 1] = v1;
    }
}

__device__ __forceinline__ void ssd_states_item(const Params& p, LAS unsigned char* lds, int item) {
    const int g = item & 3, c = (item >> 2) & 15, b = item >> 6;
    const int tid = threadIdx.x, wid = tid >> 6, lane = tid & 63, fr = lane & 15, fq = lane >> 4;
    LAS bf16_t* BsT = (LAS bf16_t*)lds;
    LAS bf16_t* XdT = (LAS bf16_t*)(lds + 34816);
    LAS float* acum = (LAS float*)(lds + 69632);
    LAS float* dts = (LAS float*)(lds + 72704);
    u32x4 rawA[7], rawB[7];
    conv_load(p, b, c, 1536 + g * 128, rawA);
    conv_load(p, b, c, (g * 6) * 64, rawB);
    ssd_acum(p, b, c, g, acum, dts);
    { float o[4][8]; int t0, co; conv_compute((const LAS float*)(lds + CW_OFF) + 3 * 640, rawA, o, t0, co);
#pragma unroll
      for (int e = 0; e < 8; ++e) { u32x2 w; w.x = pk2(o[0][e], o[1][e]); w.y = pk2(o[2][e], o[3][e]); *(LAS u32x2*)(BsT + tsw_w(co * 8 + e, t0)) = w; } }
    __syncthreads();
    bf16_t* states = (bf16_t*)(p.ws + OFF_STATES);
#pragma unroll 1
    for (int hp = 0; hp < 3; ++hp) {
        { float o[4][8]; int t0, co; conv_compute((const LAS float*)(lds + CW_OFF) + hp * 640, rawB, o, t0, co);
          if (hp < 2) conv_load(p, b, c, (g * 6 + 2 * hp + 2) * 64, rawB);
          const int hl = 2 * hp + (co >> 3); const float alast = acum[hl * 128 + 127]; float sc[4];
#pragma unroll
          for (int i = 0; i < 4; ++i) sc[i] = dts[hl * 128 + t0 + i] * __expf(alast - acum[hl * 128 + t0 + i]);
#pragma unroll
          for (int e = 0; e < 8; ++e) { u32x2 w; w.x = pk2(o[0][e] * sc[0], o[1][e] * sc[1]); w.y = pk2(o[2][e] * sc[2], o[3][e] * sc[3]); *(LAS u32x2*)(XdT + tsw_w(co * 8 + e, t0)) = w; } }
        __syncthreads();
        f32x4 acc[8];
#pragma unroll
        for (int n = 0; n < 8; ++n) acc[n] = (f32x4){0.f, 0.f, 0.f, 0.f};
#pragma unroll
        for (int kk = 0; kk < 4; ++kk) { const bf16x8 xf = *(const LAS bf16x8*)(XdT + tsw_r(wid * 16 + fr, kk * 4 + fq));
#pragma unroll
            for (int n = 0; n < 8; ++n) { const bf16x8 bf = *(const LAS bf16x8*)(BsT + tsw_r(n * 16 + fr, kk * 4 + fq)); acc[n] = __builtin_amdgcn_mfma_f32_16x16x32_bf16(bf, xf, acc[n], 0, 0, 0); } }
        const int h = g * 6 + 2 * hp + (wid >> 2), prow = (wid & 3) * 16 + fr;
        bf16_t* dst = states + ((size_t)((b * NCHUNK + c) * 24 + h) * 64 + prow) * 128 + 4 * fq;
#pragma unroll
        for (int n = 0; n < 8; ++n) { u32x2 w; w.x = pk2(acc[n][0], acc[n][1]); w.y = pk2(acc[n][2], acc[n][3]); *(u32x2*)(dst + n * 16) = w; }
        __syncthreads();
    }
    if (tid < 6) ((float*)(p.ws + OFF_CDEC))[(b * NCHUNK + c) * 24 + g * 6 + tid] = __expf(acum[tid * 128 + 127]);
    __syncthreads();
}

__device__ __forceinline__ void ssd_prefix(const Params& p) {
    bf16_t* states = (bf16_t*)(p.ws + OFF_STATES); const float* cdec = (const float*)(p.ws + OFF_CDEC);
    const int nthr = gridDim.x * 512;
    for (int v = blockIdx.x * 512 + threadIdx.x; v < NBATCH * 24 * 1024; v += nthr) {
        const int bh = v >> 10, e = v & 1023, b = bh / 24, h = bh % 24;
        u32x4 s[NCHUNK];
#pragma unroll
        for (int c = 0; c < NCHUNK; ++c) s[c] = *(const u32x4*)(states + (size_t)((b * NCHUNK + c) * 24 + h) * 8192 + e * 8);
        float prev[8];
#pragma unroll
        for (int j = 0; j < 8; ++j) prev[j] = 0.f;
#pragma unroll
        for (int c = 0; c < NCHUNK; ++c) {
            *(u32x4*)(states + (size_t)((b * NCHUNK + c) * 24 + h) * 8192 + e * 8) = pack8(prev);
            const float d = cdec[(b * NCHUNK + c) * 24 + h]; float f[8]; unpack8(s[c], f);
#pragma unroll
            for (int j = 0; j < 8; ++j) prev[j] = prev[j] * d + f[j];
        }
    }
}

__device__ __forceinline__ void ssd_out_item(const Params& p, LAS unsigned char* lds, int item) {
    const int g = item & 3, c = (item >> 2) & 15, b = item >> 6;
    const int tid = threadIdx.x, wid = tid >> 6, lane = tid & 63, fr = lane & 15, fq = lane >> 4;
    LAS bf16_t* Cs = (LAS bf16_t*)lds;
    LAS bf16_t* Bs = (LAS bf16_t*)(lds + 34816);
    LAS bf16_t* XT = (LAS bf16_t*)(lds + 69632);
    LAS float* acum = (LAS float*)(lds + 104448);
    LAS float* dts = (LAS float*)(lds + 107520);
    LAS float* red = (LAS float*)(lds + 110592);
    const size_t tok0 = (size_t)b * SEQ + c * CH;
    u32x4 rawA[7], rawB[7];
    conv_load(p, b, c, 2048 + g * 128, rawA);
    conv_load(p, b, c, 1536 + g * 128, rawB);
    ssd_acum(p, b, c, g, acum, dts);
    { float o[4][8]; int t0, co; conv_compute((const LAS float*)(lds + CW_OFF) + 4 * 640, rawA, o, t0, co);
#pragma unroll
      for (int i = 0; i < 4; ++i) *(LAS u32x4*)(Cs + (t0 + i) * LP + co * 8) = pack8(o[i]); }
    conv_load(p, b, c, (g * 6) * 64, rawA);
    { float o[4][8]; int t0, co; conv_compute((const LAS float*)(lds + CW_OFF) + 3 * 640, rawB, o, t0, co);
#pragma unroll
      for (int i = 0; i < 4; ++i) *(LAS u32x4*)(Bs + (t0 + i) * LP + co * 8) = pack8(o[i]); }
    __syncthreads();
    LAS float* vtab = (LAS float*)(lds + 125440);
    for (int idx = tid; idx < 6 * 128; idx += 512) vtab[idx] = __expf(acum[idx | 15] - acum[idx]) * dts[idx];
    f32x4 S[8];
#pragma unroll
    for (int st = 0; st < 8; ++st) S[st] = (f32x4){0.f, 0.f, 0.f, 0.f};
#pragma unroll
    for (int kk = 0; kk < 4; ++kk) { const bf16x8 cf = *(const LAS bf16x8*)(Cs + (wid * 16 + fr) * LP + kk * 32 + fq * 8);
#pragma unroll
        for (int st = 0; st < 8; ++st) if (st <= wid) { const bf16x8 bf = *(const LAS bf16x8*)(Bs + (st * 16 + fr) * LP + kk * 32 + fq * 8); S[st] = __builtin_amdgcn_mfma_f32_16x16x32_bf16(bf, cf, S[st], 0, 0, 0); } }
    __syncthreads();
    LAS bf16_t* Pb = Bs;
    const int half = wid >> 2, pt = wid & 3;
    float ssq[4] = {0.f, 0.f, 0.f, 0.f};
    const bf16_t* states = (const bf16_t*)(p.ws + OFF_STATES);
    bf16_t* segA = (bf16_t*)(p.ws + OFF_SEGA);
    bf16x8 pfn[4];
    { const bf16_t* pr = states + ((size_t)((b * NCHUNK + c) * 24 + g * 6) * 64 + pt * 16 + fr) * 128 + fq * 8;
#pragma unroll
      for (int kk = 0; kk < 4; ++kk) pfn[kk] = *(const bf16x8*)(pr + kk * 32);
 }
#pragma unroll 1
    for (int j = 0; j < 6; ++j) {
        const int hp = j >> 1, hs = j & 1, h = g * 6 + j;
        if (hs == 0) { float o[4][8]; int t0, co; conv_compute((const LAS float*)(lds + CW_OFF) + hp * 640, rawA, o, t0, co);
          if (hp < 2) conv_load(p, b, c, (g * 6 + 2 * hp + 2) * 64, rawA);
#pragma unroll
          for (int e = 0; e < 8; ++e) { u32x2 w; w.x = pk2(o[0][e], o[1][e]); w.y = pk2(o[2][e], o[3][e]); *(LAS u32x2*)(XT + tsw_w(co * 8 + e, t0)) = w; } }
        {
            bf16x8 pf[4]; u32x2 zw4[4];
#pragma unroll
            for (int kk = 0; kk < 4; ++kk) pf[kk] = pfn[kk];
#pragma unroll
            for (int q = 0; q < 4; ++q) { const int lt = half == 0 ? (q == 0 ? 0 : (q == 1 ? 3 : (q == 2 ? 4 : 7))) : (q == 0 ? 1 : (q == 1 ? 2 : (q == 2 ? 5 : 6)));
                zw4[q] = *(const u32x2*)(segA + (tok0 + lt * 16 + fr) * LDA_SEG + 1024 + h * 64 + pt * 16 + 4 * fq); }
            if (j < 5) { const bf16_t* pr = states + ((size_t)((b * NCHUNK + c) * 24 + h + 1) * 64 + pt * 16 + fr) * 128 + fq * 8;
#pragma unroll
              for (int kk = 0; kk < 4; ++kk) pfn[kk] = *(const bf16x8*)(pr + kk * 32); }
            {
              const int l = wid * 16 + fr; const float al = acum[j * 128 + l], Dh = p.ssdd[h];
#pragma unroll
              for (int st = 0; st < 8; ++st) if (st <= (wid | 1)) { float v[4];
                  if (st < wid) {
                      const float uu = __expf(al - acum[j * 128 + st * 16 + 15]); const f32x4 v4 = *(const LAS f32x4*)(vtab + j * 128 + st * 16 + 4 * fq);
#pragma unroll
                      for (int jj = 0; jj < 4; ++jj) v[jj] = S[st][jj] * uu * v4[jj];
                  } else {
                      const f32x4 as4 = *(const LAS f32x4*)(acum + j * 128 + st * 16 + 4 * fq), ds4 = *(const LAS f32x4*)(dts + j * 128 + st * 16 + 4 * fq);
#pragma unroll
                      for (int jj = 0; jj < 4; ++jj) { const int sx = st * 16 + 4 * fq + jj; float t = 0.f;
                          if (sx <= l) t = S[st][jj] * __expf(al - as4[jj]) * ds4[jj];
                          if (sx == l) t += Dh; v[jj] = t; } }
                  u32x2 w; w.x = pk2(v[0], v[1]); w.y = pk2(v[2], v[3]); *(LAS u32x2*)(Pb + l * LP + st * 16 + 4 * fq) = w; } }
            __syncthreads();
            bf16x8 xf[4];
#pragma unroll
            for (int kk = 0; kk < 4; ++kk) xf[kk] = *(const LAS bf16x8*)(XT + tsw_r(hs * 64 + pt * 16 + fr, kk * 4 + fq));
            __builtin_amdgcn_s_setprio(1);
#pragma unroll
            for (int q = 0; q < 4; ++q) {
                const int lt = half == 0 ? (q == 0 ? 0 : (q == 1 ? 3 : (q == 2 ? 4 : 7))) : (q == 0 ? 1 : (q == 1 ? 2 : (q == 2 ? 5 : 6)));
                f32x4 ad = (f32x4){0.f, 0.f, 0.f, 0.f}, ao = (f32x4){0.f, 0.f, 0.f, 0.f};
#pragma unroll
                for (int kk = 0; kk < 4; ++kk) if (kk <= (lt >> 1)) { const bf16x8 pfr = *(const LAS bf16x8*)(Pb + (lt * 16 + fr) * LP + kk * 32 + fq * 8); ad = __builtin_amdgcn_mfma_f32_16x16x32_bf16(xf[kk], pfr, ad, 0, 0, 0); }
#pragma unroll
                for (int kk = 0; kk < 4; ++kk) { const bf16x8 cfr = *(const LAS bf16x8*)(Cs + (lt * 16 + fr) * LP + kk * 32 + fq * 8); ao = __builtin_amdgcn_mfma_f32_16x16x32_bf16(pf[kk], cfr, ao, 0, 0, 0); }
                const int l = lt * 16 + fr; const float ea = __expf(acum[j * 128 + l]);
                bf16_t* zp = segA + (tok0 + l) * LDA_SEG + 1024 + h * 64 + pt * 16 + 4 * fq;
                const u32x2 zw = zw4[q];
                const float y0 = (ad[0] + ea * ao[0]) * siluf_(bflo(zw.x)), y1 = (ad[1] + ea * ao[1]) * siluf_(bfhi(zw.x)), y2 = (ad[2] + ea * ao[2]) * siluf_(bflo(zw.y)), y3 = (ad[3] + ea * ao[3]) * siluf_(bfhi(zw.y));
                ssq[q] += (y0 * y0 + y1 * y1) + (y2 * y2 + y3 * y3);
                u32x2 yo; yo.x = pk2(y0, y1); yo.y = pk2(y2, y3); if (!(p.dry & 1)) *(u32x2*)zp = yo;
            }
            __builtin_amdgcn_s_setprio(0);
            __syncthreads();
        }
    }
#pragma unroll
    for (int q = 0; q < 4; ++q) { float s = ssq[q]; s += __shfl_xor(s, 16); s += __shfl_xor(s, 32); if (fq == 0) red[wid * 64 + q * 16 + fr] = s; }
    __syncthreads();
    float rstd[4];
#pragma unroll
    for (int q = 0; q < 4; ++q) { const int o = q * 16 + fr; const float tot = (red[(half * 4 + 0) * 64 + o] + red[(half * 4 + 1) * 64 + o]) + (red[(half * 4 + 2) * 64 + o] + red[(half * 4 + 3) * 64 + o]);
        rstd[q] = rsqrtf(tot * (1.0f / 384.0f) + 1e-6f); }
#pragma unroll
    for (int j = 0; j < 6; ++j) { const int h = g * 6 + j; const f32x4 nw = *(const f32x4*)(p.ssdnw + h * 64 + pt * 16 + 4 * fq);
#pragma unroll
        for (int q = 0; q < 4; ++q) {
            const int lt = half == 0 ? (q == 0 ? 0 : (q == 1 ? 3 : (q == 2 ? 4 : 7))) : (q == 0 ? 1 : (q == 1 ? 2 : (q == 2 ? 5 : 6)));
            const int l = lt * 16 + fr; bf16_t* zp = segA + (tok0 + l) * LDA_SEG + 1024 + h * 64 + pt * 16 + 4 * fq;
            const u32x2 w = *(const u32x2*)zp; u32x2 o;
            o.x = pk2(bflo(w.x) * rstd[q] * nw[0], bfhi(w.x) * rstd[q] * nw[1]); o.y = pk2(bflo(w.y) * rstd[q] * nw[2], bfhi(w.y) * rstd[q] * nw[3]);
            if (!(p.dry & 1)) *(u32x2*)zp = o; } }
    __syncthreads();
}

template <int PASS>
__device__ __forceinline__ void s5_wave_item(const Params& p, LAS float* wl  , int item) {
    const int g = item & 31, c = (item >> 5) & 15, b = item >> 9;
    const int lane = threadIdx.x & 63, fr = lane & 15, fq = lane >> 4;
    const size_t tok0 = (size_t)b * SEQ + c * CH;
    bf16_t* segA = (bf16_t*)(p.ws + OFF_SEGA);
    const float* lam = (const float*)(p.ws + OFF_LAM); const float lr = lam[(g * 64 + lane) * 2], li = lam[(g * 64 + lane) * 2 + 1];
    float* E = (float*)(p.ws + OFF_E);
    bf16x8 bbf[8];
    { const bf16_t* bbt = (const bf16_t*)(p.ws + OFF_BBT) + (size_t)g * 128 * 32;
#pragma unroll
      for (int n = 0; n < 8; ++n) bbf[n] = *(const bf16x8*)(bbt + (n * 16 + fr) * 32 + fq * 8); }
    float sr = 0.f, si = 0.f;
    bf16x8 cwf[4]; f32x4 dv = (f32x4){0.f, 0.f, 0.f, 0.f};
    if (PASS == 2) {
        const float* lamL = (const float*)(p.ws + OFF_LAML); const float Lr = lamL[(g * 64 + lane) * 2], Li = lamL[(g * 64 + lane) * 2 + 1];
        float er[15], ei[15];
#pragma unroll
        for (int cc = 0; cc < 15; ++cc) { er[cc] = 0.f; ei[cc] = 0.f; if (cc < c) { er[cc] = E[(size_t)((b * NCHUNK + cc) * 32 + g) * 128 + lane]; ei[cc] = E[(size_t)((b * NCHUNK + cc) * 32 + g) * 128 + 64 + lane]; } }
#pragma unroll
        for (int cc = 0; cc < 15; ++cc) if (cc < c) { const float nr = Lr * sr - Li * si + er[cc], ni = Lr * si + Li * sr + ei[cc]; sr = nr; si = ni; }
        const bf16_t* cwt = (const bf16_t*)(p.ws + OFF_CWT) + (size_t)g * 16 * 128;
#pragma unroll
        for (int kk = 0; kk < 4; ++kk) cwf[kk] = *(const bf16x8*)(cwt + fr * 128 + kk * 32 + fq * 8);
        dv = *(const f32x4*)(p.s5d + g * 16 + 4 * fq);
    }
    bf16x8 ufa[8]; u32x2 uwa[8];
#pragma unroll
    for (int bt = 0; bt < 8; ++bt) { ufa[bt] = (bf16x8){0, 0, 0, 0, 0, 0, 0, 0}; uwa[bt] = (u32x2){0u, 0u};
        if (fq < 2) ufa[bt] = *(const bf16x8*)(segA + (tok0 + bt * 16 + fr) * LDA_SEG + g * 16 + fq * 8);
        if (PASS == 2) uwa[bt] = *(const u32x2*)(segA + (tok0 + bt * 16 + fr) * LDA_SEG + g * 16 + 4 * fq); }
#pragma unroll
    for (int bt = 0; bt < 8; ++bt) {
        const size_t trow = tok0 + bt * 16 + fr;
        const bf16x8 uf = ufa[bt]; const u32x2 uw = uwa[bt];
        f32x4 bu[8];
#pragma unroll
        for (int n = 0; n < 8; ++n) { bu[n] = (f32x4){0.f, 0.f, 0.f, 0.f}; bu[n] = __builtin_amdgcn_mfma_f32_16x16x32_bf16(bbf[n], uf, bu[n], 0, 0, 0); }
        asm volatile("s_nop 15\n\ts_nop 15" : "+v"(bu[0]), "+v"(bu[1]), "+v"(bu[2]), "+v"(bu[3]), "+v"(bu[4]), "+v"(bu[5]), "+v"(bu[6]), "+v"(bu[7]));
#pragma unroll
        for (int n = 0; n < 8; ++n) *(LAS f32x4*)(wl + fr * 132 + n * 16 + 4 * fq) = bu[n];
        asm volatile("s_waitcnt lgkmcnt(0)" ::: "memory"); __builtin_amdgcn_wave_barrier();
        float br[16], bi[16];
#pragma unroll
        for (int t = 0; t < 16; ++t) { br[t] = wl[t * 132 + lane]; bi[t] = wl[t * 132 + 64 + lane]; }
#pragma unroll
        for (int t = 0; t < 16; ++t) { const float nr = lr * sr - li * si + br[t], ni = lr * si + li * sr + bi[t]; sr = nr; si = ni; br[t] = sr; bi[t] = si; }
        if (PASS == 2) {
#pragma unroll
            for (int t = 0; t < 16; ++t) { wl[t * 132 + lane] = br[t]; wl[t * 132 + 64 + lane] = bi[t]; } }
        if (PASS == 2) {
            asm volatile("s_waitcnt lgkmcnt(0)" ::: "memory"); __builtin_amdgcn_wave_barrier();
            f32x4 a = (f32x4){0.f, 0.f, 0.f, 0.f};
#pragma unroll
            for (int kk = 0; kk < 4; ++kk) { const f32x4 s0 = *(const LAS f32x4*)(wl + fr * 132 + kk * 32 + fq * 8), s1 = *(const LAS f32x4*)(wl + fr * 132 + kk * 32 + fq * 8 + 4);
                u32x4 w; w.x = pk2(s0[0], s0[1]); w.y = pk2(s0[2], s0[3]); w.z = pk2(s1[0], s1[1]); w.w = pk2(s1[2], s1[3]);
                bf16x8 sf; __builtin_memcpy(&sf, &w, 16);
                a = __builtin_amdgcn_mfma_f32_16x16x32_bf16(cwf[kk], sf, a, 0, 0, 0); }
            bf16_t* up = segA + trow * LDA_SEG + g * 16 + 4 * fq;
            const float y0 = geluf_(a[0] + dv[0] * bflo(uw.x)), y1 = geluf_(a[1] + dv[1] * bfhi(uw.x)), y2 = geluf_(a[2] + dv[2] * bflo(uw.y)), y3 = geluf_(a[3] + dv[3] * bfhi(uw.y));
            u32x2 o; o.x = pk2(y0, y1); o.y = pk2(y2, y3); if (!(p.dry & 2)) *(u32x2*)up = o;
            asm volatile("s_waitcnt lgkmcnt(0)" ::: "memory"); __builtin_amdgcn_wave_barrier();
        }
    }
    if (PASS == 1) { E[(size_t)((b * NCHUNK + c) * 32 + g) * 128 + lane] = sr; E[(size_t)((b * NCHUNK + c) * 32 + g) * 128 + 64 + lane] = si; }
}

#define XB_TMO      128
#define XB_XCNT(j)  (256  + 64 * (j))
#define XB_XSUB(j)  (1280 + 64 * (j))
#define XB_XGEN(j)  (2304 + 64 * (j))
#define XB_TOP      3328
#define XB_TOPGEN   3392
#define XCD_BAR_WORDS 3456
#define XB_SPIN_CAP (1u << 18)
__device__ __forceinline__ unsigned xb_ld(unsigned* p)              { return __hip_atomic_load(p, __ATOMIC_RELAXED, __HIP_MEMORY_SCOPE_AGENT); }
__device__ __forceinline__ unsigned xb_add(unsigned* p, unsigned v) { return __hip_atomic_fetch_add(p, v, __ATOMIC_RELAXED, __HIP_MEMORY_SCOPE_AGENT); }
__device__ __forceinline__ unsigned xb_xcc_id() { return (unsigned)__builtin_amdgcn_s_getreg((3 << 11) | 20) & 0xFu; }
#define XB_SPIN(cond, bar) do { unsigned _sp = 0; while (cond) { __builtin_amdgcn_s_sleep(1); \
    if ((++_sp & 255u) == 0u) { if (xb_ld(&(bar)[XB_TMO])) break; if (_sp > XB_SPIN_CAP) { atomicAdd(&(bar)[XB_TMO], 1u); break; } } } } while (0)
struct XcdBarrier { unsigned* bar; unsigned x; volatile LAS unsigned* st; };
__device__ __forceinline__ XcdBarrier xcd_barrier_post(unsigned* bar, volatile LAS unsigned* st) {
    XcdBarrier b; b.bar = bar; b.x = xb_xcc_id(); b.st = st;
    if (threadIdx.x == 0) (void)xb_add(&bar[XB_XCNT(b.x)], 1u);
    return b;
}
__device__ __forceinline__ void xcd_barrier_complete(unsigned* bar, unsigned x, unsigned& nloc, unsigned& nx) {
    const unsigned G = gridDim.x * gridDim.y * gridDim.z;
    unsigned sum, cnt, mine, sp = 0u;
    for (;;) {
        sum = 0u; cnt = 0u; mine = 0u;
#pragma unroll
        for (unsigned j = 0; j < 16; ++j) { const unsigned c = xb_ld(&bar[XB_XCNT(j)]); sum += c; cnt += (c > 0u) ? 1u : 0u; mine = (j == x) ? c : mine; }
        if (sum == G) break;
        __builtin_amdgcn_s_sleep(1);
        if ((++sp & 255u) == 0u) { if (xb_ld(&bar[XB_TMO])) break; if (sp > XB_SPIN_CAP) { atomicAdd(&bar[XB_TMO], 1u); break; } }
    }
    nloc = mine > 0u ? mine : 1u; nx = cnt > 0u ? cnt : 1u;
}
__device__ __forceinline__ void xcd_barrier(const XcdBarrier& b) {
    asm volatile("s_waitcnt vmcnt(0)" ::: "memory");
    __syncthreads();
    if (threadIdx.x == 0) {
        unsigned* bar = b.bar;
        __builtin_amdgcn_s_waitcnt(0);
        unsigned nloc = b.st[0], nx = b.st[1];
        if (nloc == 0u) { xcd_barrier_complete(bar, b.x, nloc, nx); b.st[0] = nloc; b.st[1] = nx; }
        const unsigned old = xb_add(&bar[XB_XSUB(b.x)], 1u);
        const unsigned gen = old / nloc;
        if (old + 1u == (gen + 1u) * nloc) {
            __builtin_amdgcn_fence(__ATOMIC_RELEASE, "agent");
            asm volatile("s_waitcnt vmcnt(0)" ::: "memory");
            const unsigned og = xb_add(&bar[XB_TOP], 1u);
            const unsigned tg = og / nx;
            if (og + 1u == (tg + 1u) * nx) xb_add(&bar[XB_TOPGEN], 1u);
            else XB_SPIN(xb_ld(&bar[XB_TOPGEN]) == tg, bar);
            __builtin_amdgcn_fence(__ATOMIC_ACQUIRE, "agent");
            xb_add(&bar[XB_XGEN(b.x)], 1u);
            asm volatile("s_waitcnt vmcnt(0)" ::: "memory");
        } else {
            XB_SPIN(xb_ld(&bar[XB_XGEN(b.x)]) == gen, bar);
            __builtin_amdgcn_fence(__ATOMIC_ACQUIRE, "agent");
            asm volatile("s_waitcnt vmcnt(0)" ::: "memory");
        }
    }
    __syncthreads();
}

__global__ void __launch_bounds__(512) mega(Params p) {
    extern __shared__ __attribute__((aligned(16))) unsigned char lds_raw[];
    LAS unsigned char* lds = (LAS unsigned char*)lds_raw;
    cg::grid_group grid = cg::this_grid();
    const int lo = p.ph_lo, hi = p.ph_hi, G = gridDim.x, wg = blockIdx.x, tid = threadIdx.x, wid = tid >> 6;
    unsigned char* ws = p.ws;
#ifndef ONLY
#define ONLY -1
#endif
#define IN(k) ((ONLY < 0 || ONLY == (k)) && lo <= (k) && (k) <= hi)
#define SEAM(k) do { if (lo <= (k) && (k) < hi) xcd_barrier(xb); } while (0)
    if (lo < 0) grid.sync();
    XcdBarrier xb; xb.bar = (unsigned*)(ws + OFF_BAR); xb.x = 0; xb.st = (volatile LAS unsigned*)(lds + 131072);
    if (lo < hi) {
        if (tid < 2) xb.st[tid] = 0u;
        __syncthreads();
        xb = xcd_barrier_post((unsigned*)(ws + OFF_BAR), (volatile LAS unsigned*)(lds + 131072));
    }
    if (IN(0)) phase0(p, lds);
    SEAM(0);
    if (IN(1)) {
        {
            const int lane = tid & 63, fr = lane & 15, fq = lane >> 4;
            const bf16_t* xn = (const bf16_t*)(ws + OFF_XN); const bf16_t* wdt = (const bf16_t*)(ws + OFF_WDT); float* dtv = (float*)(ws + OFF_DTV);
            for (int rt = wg * 8 + wid; rt < T_TOK / 16; rt += G * 8) {
                f32x4 a0 = (f32x4){0.f, 0.f, 0.f, 0.f}, a1 = a0;
                const bf16_t* xr = xn + (size_t)(rt * 16 + fr) * 1024 + fq * 8; const bf16_t* w0 = wdt + (size_t)fr * 1024 + fq * 8; const bf16_t* w1 = w0 + 16 * 1024;
#pragma unroll 8
                for (int kk = 0; kk < 32; ++kk) { const bf16x8 xa = *(const bf16x8*)(xr + kk * 32), b0 = *(const bf16x8*)(w0 + kk * 32), b1 = *(const bf16x8*)(w1 + kk * 32);
                    a0 = __builtin_amdgcn_mfma_f32_16x16x32_bf16(b0, xa, a0, 0, 0, 0); a1 = __builtin_amdgcn_mfma_f32_16x16x32_bf16(b1, xa, a1, 0, 0, 0); }
                float* dr = dtv + (size_t)(rt * 16 + fr) * 24 + 4 * fq; f32x4 o0, o1;
#pragma unroll
                for (int j = 0; j < 4; ++j) { o0[j] = softplusf_(a0[j] + p.dtbias[4 * fq + j]); o1[j] = softplusf_(a1[j] + p.dtbias[(16 + 4 * fq + j) % 24]); }
                *(f32x4*)dr = o0; if (fq < 2) *(f32x4*)(dr + 16) = o1;
            }
        }
        pg8::Gemm g{(const bf16_t*)(ws + OFF_XN), (const bf16_t*)(ws + OFF_WIN), 1024, 1024, T_TOK, N_INP, 1024}; pg8::StaticOrder S; S.init(T_TOK, N_INP, G, wg);
        EpiInProj E{(bf16_t*)(ws + OFF_SEGA), (bf16_t*)(ws + OFF_SEGB), (bf16_t*)p.out, (float*)(ws + OFF_DTV), p.dtbias, p.dry};
        pg8::gemm_phase(lds, g, S, E);
    }
    SEAM(1);
    if (IN(2)) {
        if (!(p.dry & 32)) for (int it = wg; it < 1024; it += G) { if (it == wg || (G & 3)) conv_fill(p, lds, it & 3); ssd_states_item(p, lds, it); }
        for (int it = wg * 8 + wid; it < 8192; it += G * 8) if (((it >> 5) & 15) != 15) s5_wave_item<1>(p, (LAS float*)(lds + wid * 8448), it);
    }
    SEAM(2);
    if (IN(3)) {
        const bool s5first = (wg & 1) != 0;
        if (!s5first) ssd_prefix(p);
        for (int it = wg * 8 + wid; it < 8192; it += G * 8) s5_wave_item<2>(p, (LAS float*)(lds + wid * 8448), it);
        if (s5first) ssd_prefix(p);
        __syncthreads();
        xpose_tiles<0>(p.wbr5, 1024, 512, (bf16_t*)(ws + OFF_W5T), 1024, nullptr, (LAS float*)lds, wg, G);
        xpose_tiles<0>(p.wbrs, 1024, 1536, (bf16_t*)(ws + OFF_WSST), 1024, nullptr, (LAS float*)lds, wg, G);
        xpose_tiles<0>(p.wout, 1024, 1024, (bf16_t*)(ws + OFF_WOUTT), 1024, nullptr, (LAS float*)lds, wg, G);
        xpose_tiles<0>(p.wpg, 1024, 1024, (bf16_t*)(ws + OFF_WPGT), 1024, p.plenw, (LAS float*)lds, wg, G);
        xpose_tiles<0>(p.wpp, 1024, 256, (bf16_t*)(ws + OFF_WPPT), 1024, nullptr, (LAS float*)lds, wg, G);
        { bf16_t* pbf = (bf16_t*)(ws + OFF_PBF); const int nthr = G * 512;
          for (int v = wg * 512 + tid; v < T_TOK * 256 / 8; v += nthr) { const f32x4 a = *(const f32x4*)(p.p + (size_t)v * 8), bq = *(const f32x4*)(p.p + (size_t)v * 8 + 4);
              u32x4 w; w.x = pk2(a[0], a[1]); w.y = pk2(a[2], a[3]); w.z = pk2(bq[0], bq[1]); w.w = pk2(bq[2], bq[3]); *(u32x4*)(pbf + (size_t)v * 8) = w; } }
    }
    SEAM(3);
    if (IN(4)) {
        if (!(wg & 1)) {
        { pg8::Gemm g{(const bf16_t*)(ws + OFF_SEGA), (const bf16_t*)(ws + OFF_WGLU), LDA_SEG, 512, T_TOK, 512, 512}; pg8::StaticOrder S; S.init(T_TOK, 512, G, wg);
          EpiGlu E{(bf16_t*)(ws + OFF_SEGA), p.bglu}; pg8::gemm_phase(lds, g, S, E); }
        __syncthreads(); }
#ifndef NO_SSD_OUT
        if (p.dry != 2) for (int it = wg; it < 1024; it += G) { if (it == wg || (G & 3)) conv_fill(p, lds, it & 3); ssd_out_item(p, lds, it); }
#endif
        if (wg & 1) { __syncthreads();
        { pg8::Gemm g{(const bf16_t*)(ws + OFF_SEGA), (const bf16_t*)(ws + OFF_WGLU), LDA_SEG, 512, T_TOK, 512, 512}; pg8::StaticOrder S; S.init(T_TOK, 512, G, wg);
          EpiGlu E{(bf16_t*)(ws + OFF_SEGA), p.bglu}; pg8::gemm_phase(lds, g, S, E); }
        }
    }
    SEAM(4);
    if (IN(6)) {
        { pg8::Gemm g{(const bf16_t*)(ws + OFF_SEGA) + 512, (const bf16_t*)(ws + OFF_W5T), LDA_SEG, 512, T_TOK, 1024, 512}; pg8::StaticOrder S; S.init(T_TOK, 1024, G, wg);
          EpiMerge<0> E{(bf16_t*)(ws + OFF_M5), (const bf16_t*)p.out, nullptr}; pg8::gemm_phase(lds, g, S, E); }
        { pg8::Gemm g{(const bf16_t*)(ws + OFF_SEGA) + 1024, (const bf16_t*)(ws + OFF_WSST), LDA_SEG, 1536, T_TOK, 1024, 1536}; pg8::StaticOrder S; S.init(T_TOK, 1024, G, wg);
          EpiMerge<1> E{(bf16_t*)(ws + OFF_MERGED), (const bf16_t*)p.out, (const bf16_t*)(ws + OFF_M5)}; pg8::gemm_phase(lds, g, S, E); }
    }
    SEAM(6);
    if (IN(7)) {
        pg8::Gemm g{(const bf16_t*)(ws + OFF_MERGED), (const bf16_t*)(ws + OFF_WOUTT), 1024, 1024, T_TOK, 1024, 1024}; pg8::StaticOrder S; S.init(T_TOK, 1024, G, wg);
        EpiOut E{p.x, (bf16_t*)(ws + OFF_M5), (float*)(ws + OFF_SS1)}; pg8::gemm_phase(lds, g, S, E);
    }
    SEAM(7);
    if (IN(8)) {
        { pg8::Gemm g{(const bf16_t*)(ws + OFF_PBF), (const bf16_t*)(ws + OFF_WPPT), 256, 256, T_TOK, 1024, 256}; pg8::StaticOrder S; S.init(T_TOK, 1024, G, wg);
          EpiMerge<2> E{(bf16_t*)(ws + OFF_PLEP), nullptr, nullptr}; pg8::gemm_phase(lds, g, S, E); }
        { pg8::Gemm g{(const bf16_t*)(ws + OFF_M5), (const bf16_t*)(ws + OFF_WPGT), 1024, 1024, T_TOK, 1024, 1024}; pg8::StaticOrder S; S.init(T_TOK, 1024, G, wg);
          EpiPle E{(const bf16_t*)(ws + OFF_M5), (bf16_t*)(ws + OFF_SEGA), (const bf16_t*)(ws + OFF_PLEP), (const float*)(ws + OFF_SS1), (float*)(ws + OFF_SS2)}; pg8::gemm_phase(lds, g, S, E); }
    }
    SEAM(8);
    if (IN(9)) {
        const int lane = tid & 63; const float* ss2 = (const float*)(ws + OFF_SS2);
        for (int row0 = (wg * 8 + wid) * 2; row0 < T_TOK; row0 += G * 16) {
            u32x2 hw[2][4]; float r[2];
#pragma unroll
            for (int rr = 0; rr < 2; ++rr) { const u32x2* hp2 = (const u32x2*)((const bf16_t*)(ws + OFF_SEGA) + (size_t)(row0 + rr) * DM);
#pragma unroll
                for (int i = 0; i < 4; ++i) hw[rr][i] = hp2[lane + 64 * i];
                float s = lane < 16 ? ss2[(size_t)(row0 + rr) * 16 + lane] : 0.f; s = wave_sum(s); r[rr] = rsqrtf(s * (1.0f / 1024.0f) + 1e-6f); }
#pragma unroll
            for (int i = 0; i < 4; ++i) { const f32x4 w = ((const f32x4*)p.fnw)[lane + 64 * i];
#pragma unroll
                for (int rr = 0; rr < 2; ++rr) { f32x4 v; v[0] = bflo(hw[rr][i].x) * r[rr] * w[0]; v[1] = bfhi(hw[rr][i].x) * r[rr] * w[1]; v[2] = bflo(hw[rr][i].y) * r[rr] * w[2]; v[3] = bfhi(hw[rr][i].y) * r[rr] * w[3];
                    ((f32x4*)(p.out + (size_t)(row0 + rr) * DM))[lane + 64 * i] = v; } }
        }
    }
#undef IN
#undef SEAM
}

#ifndef N_LAUNCH_MODE
#define N_LAUNCH_MODE 1
#endif
extern "C" void kernel_launch(void* const* d_in, const int* in_sizes, int n_in, void* d_out, int out_size, void* d_ws, size_t ws_size, hipStream_t stream) {
    static int grid = 0;
    if (grid == 0) {
        if (n_in != 27 || ws_size < WS_NEED) { fprintf(stderr, "kernel_launch: need 27 inputs and >= %zu bytes of workspace; got %d, %zu\n", (size_t)WS_NEED, n_in, ws_size); grid = -1; return; }
        int dev = 0, cus = 0, per_cu = 0;
        hipGetDevice(&dev); hipDeviceGetAttribute(&cus, hipDeviceAttributeMultiprocessorCount, dev);
        if (hipFuncSetAttribute((const void*)mega, hipFuncAttributeMaxDynamicSharedMemorySize, LDS_BYTES) != hipSuccess) { fprintf(stderr, "kernel_launch: hipFuncSetAttribute failed\n"); grid = -1; return; }
        if (hipOccupancyMaxActiveBlocksPerMultiprocessor(&per_cu, (const void*)mega, 512, LDS_BYTES) != hipSuccess || per_cu < 1) { fprintf(stderr, "kernel_launch: occupancy query says %d blocks per CU\n", per_cu); per_cu = 1; }
        (void)hipGetLastError();
        grid = cus;
    }
    if (grid < 0) return;
    Params p{};
    const float** pp = (const float**)&p;
    for (int i = 0; i < 27; ++i) pp[i] = (const float*)d_in[i];
    p.out = (float*)d_out; p.ws = (unsigned char*)d_ws;
#if N_LAUNCH_MODE == 1
    hipMemsetAsync((unsigned char*)d_ws + OFF_BAR, 0, XCD_BAR_WORDS * 4, stream);
    p.ph_lo = 0; p.ph_hi = 9;
    void* args[] = {&p};
    hipError_t e = hipLaunchCooperativeKernel((const void*)mega, dim3(grid), dim3(512), args, LDS_BYTES, stream);
    if (e != hipSuccess) fprintf(stderr, "cooperative launch failed: %s (grid %d)\n", hipGetErrorString(e), grid);
#else
#ifndef PROBE_DUP2
#define PROBE_DUP2 -1
#endif
#ifndef PROBE_DUP
#define PROBE_DUP -1
#endif
#ifndef PROBE_DRY4
#define PROBE_DRY4 0
#endif
    for (int k = 0; k < 10; ++k) { p.ph_lo = k; p.ph_hi = k;
#ifndef PROBE_DRY1
#define PROBE_DRY1 0
#endif
#ifndef PROBE_DRY2
#define PROBE_DRY2 0
#endif
        if (k == 2 && PROBE_DRY2) { p.dry = 32; hipLaunchKernelGGL(mega, dim3(grid), dim3(512), LDS_BYTES, stream, p); p.dry = 0; }
        if (k == 1 && PROBE_DRY1) { p.dry = 4; hipLaunchKernelGGL(mega, dim3(grid), dim3(512), LDS_BYTES, stream, p); p.dry = 0; }
        if (k == 4 && PROBE_DRY4) { p.dry = PROBE_DRY4; hipLaunchKernelGGL(mega, dim3(grid), dim3(512), LDS_BYTES, stream, p); p.dry = 0; }
        hipLaunchKernelGGL(mega, dim3(grid), dim3(512), LDS_BYTES, stream, p);
        if (k == PROBE_DUP || k == PROBE_DUP2) hipLaunchKernelGGL(mega, dim3(grid), dim3(512), LDS_BYTES, stream, p); }
#endif
}
```
